# Optimizing an MI355X kernel written in HIP

```python
import math
import jax, jax.numpy as jnp
from jax import lax
import numpy as np

D_MODEL = 1024
BATCH = 8
SEQ = 4096
DEPTH = 1

N_META = 16
SSD_HEAD_DIM = 64
SSD_INNER = D_MODEL
SSD_HEADS = SSD_INNER // SSD_HEAD_DIM
SSD_GROUPS = 2
SSD_STATE = 128
SSD_CONV = 4
CHUNK = 128
SB_HEAD_DIM = 64
SB_WIDTH = D_MODEL
SB_HEADS = SB_WIDTH // SB_HEAD_DIM
Q_BLOCK = 128
MIX_WIDTH = SSD_INNER + SB_WIDTH
D_FF = 256 * ((8 * D_MODEL // 3 + 255) // 256)
FFN_CONV = 3
EPS = 1e-6

XBC_WIDTH = SSD_INNER + 2 * SSD_GROUPS * SSD_STATE
OFF_Z = 0
OFF_XBC = OFF_Z + SSD_INNER
OFF_DT = OFF_XBC + XBC_WIDTH
OFF_Q = OFF_DT + SSD_HEADS
OFF_K = OFF_Q + SB_WIDTH
OFF_V = OFF_K + SB_WIDTH
IN_COLS = OFF_V + SB_WIDTH

kernel_name = "hymba_ssd_stickbreaking_convffn_layer"


def rms_norm(x, g):
    x32 = x.astype(jnp.float32)
    y = x32 * lax.rsqrt(jnp.mean(x32 * x32, axis=-1, keepdims=True) + EPS)
    return (y * g.astype(jnp.float32)).astype(x.dtype)


def causal_dwconv(x, w, b):
    K = w.shape[0]
    L = x.shape[1]
    xp = jnp.pad(x, ((0, 0), (K - 1, 0), (0, 0)))
    y = b
    for k in range(K):
        y = y + xp[:, k:k + L] * w[k]
    return y


def ssd_mixer(z, xbc, dt_raw, conv_w, conv_b, dt_bias, a_log, d_skip, norm_g):
    out_dtype = z.dtype
    Bsz, L, _ = xbc.shape
    H, P, G, N = SSD_HEADS, SSD_HEAD_DIM, SSD_GROUPS, SSD_STATE
    J = H // G
    f32 = jnp.float32
    xbc = jax.nn.silu(causal_dwconv(xbc, conv_w, conv_b)).astype(f32)
    xs = xbc[..., :SSD_INNER].reshape(Bsz, L, H, P)
    Bm = xbc[..., SSD_INNER:SSD_INNER + G * N].reshape(Bsz, L, G, N)
    Cm = xbc[..., SSD_INNER + G * N:].reshape(Bsz, L, G, N)
    dt = jax.nn.softplus(dt_raw.astype(f32) + dt_bias.astype(f32))
    A = -jnp.exp(a_log.astype(f32))

    pad = CHUNK - N_META
    Lp = L + pad
    nc = Lp // CHUNK

    def front_pad(t):
        return jnp.pad(t, ((0, 0), (pad, 0)) + ((0, 0),) * (t.ndim - 2))

    Xdt = front_pad(xs * dt[..., None]).reshape(Bsz, nc, CHUNK, G, J, P)
    Adt = front_pad(dt * A).reshape(Bsz, nc, CHUNK, G, J).transpose(0, 3, 4, 1, 2)
    Bc = front_pad(Bm).reshape(Bsz, nc, CHUNK, G, N)
    Cc = front_pad(Cm).reshape(Bsz, nc, CHUNK, G, N)

    Acs = jnp.cumsum(Adt, axis=-1)
    causal = jnp.tril(jnp.ones((CHUNK, CHUNK), dtype=bool))
    seg = Acs[..., :, None] - Acs[..., None, :]
    Ldec = jnp.where(causal, jnp.exp(jnp.where(causal, seg, 0.0)), 0.0)

    CB = jnp.einsum('bclgn,bcsgn->bgcls', Cc, Bc)
    y_diag = jnp.einsum('bgcls,bgjcls,bcsgjp->bclgjp', CB, Ldec, Xdt)

    decay_states = jnp.exp(Acs[..., -1:] - Acs)
    states = jnp.einsum('bclgn,bgjcl,bclgjp->bcgjpn', Bc, decay_states, Xdt)
    chunk_decay = jnp.exp(Acs[..., -1])

    def step(carry, inp):
        st, dec = inp
        return carry * dec[..., None, None] + st, carry

    init = jnp.zeros((Bsz, G, J, P, N), f32)
    _, prev = lax.scan(step, init, (states.transpose(1, 0, 2, 3, 4, 5),
                                    chunk_decay.transpose(3, 0, 1, 2)))
    prev = prev.transpose(1, 0, 2, 3, 4, 5)

    y_off = jnp.einsum('bclgn,bcgjpn,bgjcl->bclgjp', Cc, prev, jnp.exp(Acs))

    y = (y_diag + y_off).reshape(Bsz, Lp, H, P)[:, pad:]
    y = y + xs * d_skip.astype(f32)[:, None]
    y = y.reshape(Bsz, L, SSD_INNER) * jax.nn.silu(z.astype(f32))
    return rms_norm(y, norm_g).astype(out_dtype)


def stick_breaking_attention(q, k, v):
    out_dtype = q.dtype
    Bsz, L, H, D = q.shape
    f32 = jnp.float32
    scale = 1.0 / math.sqrt(D)
    pad = Q_BLOCK - N_META
    Lp = L + pad
    nb = Lp // Q_BLOCK
    padw = ((0, 0), (pad, 0), (0, 0), (0, 0))
    qp = jnp.pad(q.astype(f32), padw)
    kp = jnp.pad(k.astype(f32), padw)
    vp = jnp.pad(v.astype(f32), padw)
    qb = qp.reshape(Bsz, nb, Q_BLOCK, H, D).transpose(1, 0, 2, 3, 4)
    key_pos = jnp.arange(Lp)

    def block(args):
        i, qi = args
        q_pos = i * Q_BLOCK + jnp.arange(Q_BLOCK)
        valid = (key_pos[None, :] < q_pos[:, None]) & (key_pos[None, :] >= pad)
        zlog = jnp.einsum('bqhd,bkhd->bhqk', qi, kp) * scale
        log_beta = jax.nn.log_sigmoid(zlog)
        log_keep = jnp.where(valid, log_beta - zlog, 0.0)
        after = lax.cumsum(log_keep, axis=3, reverse=True) - log_keep
        w = jnp.where(valid, jnp.exp(log_beta + after), 0.0)
        return jnp.einsum('bhqk,bkhd->bqhd', w, vp)

    o = lax.map(block, (jnp.arange(nb), qb))
    o = o.transpose(1, 0, 2, 3, 4).reshape(Bsz, Lp, H, D)[:, pad:]
    return o.astype(out_dtype)


def setup_inputs(seed: int = 0) -> dict:
    key = jax.random.key(seed)
    ks = jax.random.split(key, 20)
    f32 = jnp.float32

    def gain(k, n):
        return 1.0 + 0.05 * jax.random.normal(k, (DEPTH, n), f32)

    dt0 = jnp.exp(jax.random.uniform(ks[5], (DEPTH, SSD_HEADS), f32,
                                     math.log(1e-3), math.log(1e-1)))
    dt_bias = dt0 + jnp.log(-jnp.expm1(-dt0))
    return {
        "x": jax.random.normal(ks[0], (BATCH, SEQ, D_MODEL), f32),
        "meta_tokens": jax.random.normal(ks[1], (N_META, D_MODEL), f32),
        "mix_pre_g": gain(ks[2], D_MODEL),
        "w_in": jax.random.normal(ks[3], (DEPTH, D_MODEL, IN_COLS), f32) * D_MODEL ** -0.5,
        "ssd_conv_w": jax.random.normal(ks[4], (DEPTH, SSD_CONV, XBC_WIDTH), f32) * SSD_CONV ** -0.5,
        "ssd_conv_b": 0.01 * jax.random.normal(ks[6], (DEPTH, XBC_WIDTH), f32),
        "ssd_dt_bias": dt_bias,
        "ssd_a_log": jnp.log(jax.random.uniform(ks[7], (DEPTH, SSD_HEADS), f32, 1.0, 16.0)),
        "ssd_d": 1.0 + 0.1 * jax.random.normal(ks[8], (DEPTH, SSD_HEADS), f32),
        "ssd_norm_g": gain(ks[9], SSD_INNER),
        "sb_norm_g": gain(ks[10], SB_WIDTH),
        "w_out": jax.random.normal(ks[11], (DEPTH, MIX_WIDTH, D_MODEL), f32) * MIX_WIDTH ** -0.5,
        "mix_post_g": gain(ks[12], D_MODEL),
        "ffn_pre_g": gain(ks[13], D_MODEL),
        "w_up": jax.random.normal(ks[14], (DEPTH, D_MODEL, 2 * D_FF), f32) * D_MODEL ** -0.5,
        "ffn_conv_w": jax.random.normal(ks[15], (DEPTH, FFN_CONV, D_FF), f32) * FFN_CONV ** -0.5,
        "ffn_conv_b": 0.01 * jax.random.normal(ks[16], (DEPTH, D_FF), f32),
        "w_down": jax.random.normal(ks[17], (DEPTH, D_FF, D_MODEL), f32) * D_FF ** -0.5,
        "ffn_post_g": gain(ks[18], D_MODEL),
    }


def reference(x, meta_tokens, mix_pre_g, w_in, ssd_conv_w, ssd_conv_b, ssd_dt_bias,
              ssd_a_log, ssd_d, ssd_norm_g, sb_norm_g, w_out, mix_post_g, ffn_pre_g,
              w_up, ffn_conv_w, ffn_conv_b, w_down, ffn_post_g):
    Bsz = x.shape[0]
    meta = jnp.broadcast_to(meta_tokens.astype(x.dtype)[None], (Bsz, N_META, x.shape[-1]))
    h = jnp.concatenate([meta, x], axis=1)
    L = h.shape[1]
    for l in range(DEPTH):
        xn = rms_norm(h, mix_pre_g[l])
        proj = xn @ w_in[l]
        z = proj[..., OFF_Z:OFF_XBC]
        xbc = proj[..., OFF_XBC:OFF_DT]
        dt_raw = proj[..., OFF_DT:OFF_Q]
        q = proj[..., OFF_Q:OFF_K].reshape(Bsz, L, SB_HEADS, SB_HEAD_DIM)
        k = proj[..., OFF_K:OFF_V].reshape(Bsz, L, SB_HEADS, SB_HEAD_DIM)
        v = proj[..., OFF_V:IN_COLS].reshape(Bsz, L, SB_HEADS, SB_HEAD_DIM)
        y_ssd = ssd_mixer(z, xbc, dt_raw, ssd_conv_w[l], ssd_conv_b[l], ssd_dt_bias[l],
                          ssd_a_log[l], ssd_d[l], ssd_norm_g[l])
        y_sb = rms_norm(stick_breaking_attention(q, k, v).reshape(Bsz, L, SB_WIDTH), sb_norm_g[l])
        mix = jnp.concatenate([y_ssd, y_sb], axis=-1) @ w_out[l]
        h = h + rms_norm(mix, mix_post_g[l])
        xn = rms_norm(h, ffn_pre_g[l])
        gu = xn @ w_up[l]
        g = causal_dwconv(gu[..., :D_FF], ffn_conv_w[l], ffn_conv_b[l])
        f = (jax.nn.gelu(g, approximate=True) * gu[..., D_FF:]) @ w_down[l]
        h = h + rms_norm(f, ffn_post_g[l])
    return h[:, N_META:]
```

```cpp
#include <hip/hip_runtime.h>
#include <hip/hip_cooperative_groups.h>
#include <cstdio>
#include <cstdint>
namespace cg = cooperative_groups;

#define LAS __attribute__((address_space(3)))
typedef unsigned short bf16_t;
typedef short bf16x8 __attribute__((ext_vector_type(8)));
typedef float f32x4 __attribute__((ext_vector_type(4)));
typedef float f32x16 __attribute__((ext_vector_type(16)));
typedef unsigned u32x4 __attribute__((ext_vector_type(4)));
typedef unsigned u32x2 __attribute__((ext_vector_type(2)));

constexpr int NB = 8, SEQ = 4096, NMETA = 16, LL = SEQ + NMETA  , TT = NB * LL  , MP = 33024  , DM = 1024;
constexpr int INC = 5648, NP1 = 5888  , LDP = 5648;
constexpr int OFF_Z = 0, OFF_XBC = 1024, OFF_DT = 2560, OFF_Q = 2576, OFF_K = 3600, OFF_V = 4624;
constexpr int XBCW = 1536, DFF = 2816, NUP = 5632, MIXW = 2048;
constexpr float EPS = 1e-6f;
constexpr int NWAVES = 8, NTHR = 512;
constexpr int LDS_BYTES = 163840;
constexpr int LDS_MISC = LDS_BYTES - 64;

constexpr size_t MiB = 1u << 20;
constexpr size_t WS_WUP = 1 * MiB, WS_WDN = 12 * MiB, WS_WIN = 18 * MiB, WS_WOUT = 30 * MiB;
constexpr size_t WS_PROJ = 34 * MiB;
constexpr size_t WS_YSSD = 390 * MiB;
constexpr size_t WS_MIXIN = 34 * MiB;
constexpr size_t WS_MIX = 170 * MiB;
constexpr size_t WS_FB = 200 * MiB;
constexpr size_t WS_H1 = 383 * MiB;
constexpr size_t WS_ACT = 18 * MiB;
constexpr size_t WS_NEED = 512 * MiB;

namespace pg8 {
constexpr int BM = 256, BK = 64, HALF = 128, HTB = HALF * BK * 2, STAGE_BYTES = 8 * HTB, NXCD = 8, WGM = 8;
__host__ __device__ __forceinline__ int lds_byte(int r, int c) { const int st = (r >> 4) * 2 + (c >> 5), rr = r & 15, cc = c & 31, ob = rr * 64 + cc * 2; return st * 1024 + (ob ^ (((ob >> 9) & 1) << 5)); }
__host__ __device__ __forceinline__ void stage_rc(int b, int& R, int& C) { const int st = b / 1024, sb = b % 1024, swz = sb ^ (((sb >> 9) & 1) << 5); R = (st >> 1) * 16 + swz / 64; C = (st & 1) * 32 + (swz % 64) / 2; }
__host__ __device__ __forceinline__ int perm32(int rho) { const int n = rho >> 4, i = rho & 15; return 8 * (i >> 2) + 4 * n + (i & 3); }

struct Unit { int pm, pn; };
struct Gemm { const bf16_t* A; const bf16_t* Bt; int M, N, K, lda, ldb, mstride, moff; };

struct StaticOrder {
    int nM, nN, nwg, G, c;
    __host__ __device__ void init(int M, int N, int G_, int c_) { nM = M / BM; nN = N / BM; nwg = nM * nN; G = G_; c = c_; }
    __host__ __device__ bool next(int i, Unit& u) const {
        const long L = (long)i * G + c; if (L >= nwg) return false;
        int wgid = (int)L; { const int q = nwg / NXCD, r = nwg % NXCD, xcd = wgid % NXCD, off = wgid / NXCD; wgid = (xcd < r ? xcd * (q + 1) : r * (q + 1) + (xcd - r) * q) + off; }
        const int nig = WGM * nN, gid = wgid / nig, fm = gid * WGM, gsz = (nM - fm) < WGM ? (nM - fm) : WGM;
        u.pm = fm + ((wgid % nig) % gsz); u.pn = (wgid % nig) / gsz; return true;
    }
};

__device__ __forceinline__ unsigned cvt_pk_bf16(float lo, float hi) { unsigned r; asm volatile("v_cvt_pk_bf16_f32 %0, %1, %2" : "=v"(r) : "v"(lo), "v"(hi)); return r; }

struct EpiBf16 {
    static constexpr bool PERM = true;
    bf16_t* O; int ldc; int ncols; bf16_t* O2; int ld2; int rt_lo, rt_hi, col2_0;
    __device__ __forceinline__ void operator()(const f32x4 (&acc)[2][2][4][2], const Unit& u, int wr, int wc, int fr, int fq, LAS unsigned char* hb) const {
        const int row0 = u.pm * BM + wr * 64 + fr; const int col0 = u.pn * BM + wc * 32 + 8 * fq;
        const bool redir = (u.pn >= rt_lo && u.pn < rt_hi);
        bf16_t* base = redir ? O2 : O; const int ld = redir ? ld2 : ldc; const int cofs = redir ? col2_0 : 0;
#pragma unroll
        for (int ai = 0; ai < 2; ++ai)
#pragma unroll
            for (int m = 0; m < 4; ++m) { bf16_t* rowp = base + (size_t)(row0 + ai * HALF + m * 16) * ld + (col0 - cofs);
#pragma unroll
                for (int bj = 0; bj < 2; ++bj) { const f32x4 v0 = acc[ai][bj][m][0], v1 = acc[ai][bj][m][1];
                    u32x4 w; w.x = cvt_pk_bf16(v0[0], v0[1]); w.y = cvt_pk_bf16(v0[2], v0[3]); w.z = cvt_pk_bf16(v1[0], v1[1]); w.w = cvt_pk_bf16(v1[2], v1[3]);
                    if (col0 + bj * HALF < ncols) *(u32x4*)(rowp + bj * HALF) = w; } }
    }
};
template <bool REMAP> struct EpiF32 {
    static constexpr bool PERM = false;
    float* O; int ldc;
    __device__ __forceinline__ void operator()(const f32x4 (&acc)[2][2][4][2], const Unit& u, int wr, int wc, int fr, int fq, LAS unsigned char* hb) const {
        const int col0 = u.pn * BM + wc * 32 + 4 * fq;
#pragma unroll
        for (int ai = 0; ai < 2; ++ai)
#pragma unroll
            for (int m = 0; m < 4; ++m) { int row = u.pm * BM + ai * HALF + wr * 64 + m * 16 + fr; bool ok = true;
                if (REMAP) { const int b = row / LL, p = row - b * LL; ok = (row < TT) && (p >= NMETA); row = b * SEQ + p - NMETA; }
                if (ok) { float* rowp = O + (size_t)row * ldc + col0;
#pragma unroll
                    for (int bj = 0; bj < 2; ++bj)
#pragma unroll
                        for (int n = 0; n < 2; ++n) *(f32x4*)(rowp + bj * HALF + n * 16) = acc[ai][bj][m][n]; } }
    }
};


template <int D> __device__ __forceinline__ float dpp_row_shr(float oldv, float v) {
    return __builtin_bit_cast(float, __builtin_amdgcn_update_dpp(__builtin_bit_cast(int, oldv), __builtin_bit_cast(int, v), 0x110 + D, 0xf, 0xf, false)); }
__device__ __forceinline__ unsigned pk2e(float lo, float hi) { typedef __bf16 b2 __attribute__((ext_vector_type(2))); b2 v; v.x = (__bf16)lo; v.y = (__bf16)hi; return __builtin_bit_cast(unsigned, v); }
__device__ __forceinline__ void unpack8(const u32x4 q, float (&o)[8]) {
    o[0] = __builtin_bit_cast(float, q.x << 16); o[1] = __builtin_bit_cast(float, q.x & 0xffff0000u); o[2] = __builtin_bit_cast(float, q.y << 16); o[3] = __builtin_bit_cast(float, q.y & 0xffff0000u);
    o[4] = __builtin_bit_cast(float, q.z << 16); o[5] = __builtin_bit_cast(float, q.z & 0xffff0000u); o[6] = __builtin_bit_cast(float, q.w << 16); o[7] = __builtin_bit_cast(float, q.w & 0xffff0000u); }
__device__ __forceinline__ float ex2(float x) { return __builtin_amdgcn_exp2f(x); }

struct EpiProjConv {
    static constexpr bool PERM = true;
    bf16_t* O; const float* cw; const float* cb;
    __device__ __forceinline__ void operator()(const f32x4 (&acc)[2][2][4][2], const Unit& u, int wr, int wc, int fr, int fq, LAS unsigned char* hb) const {
        constexpr int H = 3, NCH = 256;
        int chl = wc * 32 + 8 * fq; asm volatile("" : "+v"(chl), "+v"(fr));
        const int R0 = 253 * u.pm - 3;
        const bool convt = (u.pn >= 4 && u.pn < 10);
        if (!convt) {
            const int col0 = u.pn * BM + chl;
#pragma unroll
            for (int ai = 0; ai < 2; ++ai)
#pragma unroll
                for (int m = 0; m < 4; ++m) { const int lr = ai * HALF + wr * 64 + m * 16 + fr, R = R0 + lr;
                    if (lr >= H && R < TT) { char* rowp = (char*)O + ((unsigned)R * (unsigned)LDP + (unsigned)col0) * 2u;
#pragma unroll
                        for (int bj = 0; bj < 2; ++bj) { const f32x4 v0 = acc[ai][bj][m][0], v1 = acc[ai][bj][m][1];
                            u32x4 w; w.x = pk2e(v0[0], v0[1]); w.y = pk2e(v0[2], v0[3]); w.z = pk2e(v1[0], v1[1]); w.w = pk2e(v1[2], v1[3]);
                            if (col0 + bj * HALF < INC) *(u32x4*)(rowp + bj * HALF * 2) = w; } } }
            return;
        }
        if (fr >= 16 - H) {
#pragma unroll
            for (int ai = 0; ai < 2; ++ai)
#pragma unroll
                for (int m = 0; m < 4; ++m) { const int q = 8 * ai + 4 * wr + m; asm volatile("" ::: "memory");
#pragma unroll
                    for (int bj = 0; bj < 2; ++bj) { const f32x4 v0 = acc[ai][bj][m][0], v1 = acc[ai][bj][m][1];
                        u32x4 w; w.x = pk2e(v0[0], v0[1]); w.y = pk2e(v0[2], v0[3]); w.z = pk2e(v1[0], v1[1]); w.w = pk2e(v1[2], v1[3]);
                        *(LAS u32x4*)(hb + ((q * H + fr - (16 - H)) * NCH + bj * HALF + chl) * 2) = w; } }
        }
        asm volatile("s_waitcnt lgkmcnt(0)" ::: "memory"); __builtin_amdgcn_s_barrier(); asm volatile("" ::: "memory");
        const int hr1 = H - 1, hr2 = (H - 2 + fr) < (H - 1) ? (H - 2 + fr) : (H - 1), hr3 = (H - 3 + fr) < (H - 1) ? (H - 3 + fr) : (H - 1);
        const int ch0 = (u.pn - 4) * BM + chl;
#pragma unroll
        for (int ai = 0; ai < 2; ++ai)
#pragma unroll
            for (int m = 0; m < 4; ++m) { asm volatile("" ::: "memory"); __builtin_amdgcn_sched_barrier(0);
                const int q = 8 * ai + 4 * wr + m, prev = q > 0 ? q - 1 : 0; const int lr = ai * HALF + wr * 64 + m * 16 + fr, R = R0 + lr;
                const int Rc = R < 0 ? 0 : R; const int b = Rc / LL, p = Rc - b * LL;
                const bool ok = (lr >= H && R < TT);
                const unsigned ooff = ((unsigned)Rc * (unsigned)LDP + (unsigned)(OFF_XBC + ch0)) * 2u;
#pragma unroll
                for (int bn = 0; bn < 4; ++bn) { const int bj = bn >> 1, n = bn & 1; const int co = bj * HALF + 4 * n;
                    const unsigned woff = (unsigned)(ch0 + co) * 4u;
                    const f32x4 w0 = *(const f32x4*)((const char*)cw + woff), w1 = *(const f32x4*)((const char*)cw + woff + XBCW * 4), w2 = *(const f32x4*)((const char*)cw + woff + 2 * XBCW * 4), w3 = *(const f32x4*)((const char*)cw + woff + 3 * XBCW * 4), bs = *(const f32x4*)((const char*)cb + woff);
                    const LAS unsigned char* hp = hb + (prev * H * NCH + chl + co) * 2;
                    const u32x2 q1 = *(const LAS u32x2*)(hp + hr1 * NCH * 2), q2 = *(const LAS u32x2*)(hp + hr2 * NCH * 2), q3 = *(const LAS u32x2*)(hp + hr3 * NCH * 2);
                    const float h1[4] = {__builtin_bit_cast(float, q1.x << 16), __builtin_bit_cast(float, q1.x & 0xffff0000u), __builtin_bit_cast(float, q1.y << 16), __builtin_bit_cast(float, q1.y & 0xffff0000u)};
                    const float h2[4] = {__builtin_bit_cast(float, q2.x << 16), __builtin_bit_cast(float, q2.x & 0xffff0000u), __builtin_bit_cast(float, q2.y << 16), __builtin_bit_cast(float, q2.y & 0xffff0000u)};
                    const float h3[4] = {__builtin_bit_cast(float, q3.x << 16), __builtin_bit_cast(float, q3.x & 0xffff0000u), __builtin_bit_cast(float, q3.y << 16), __builtin_bit_cast(float, q3.y & 0xffff0000u)};
                    const f32x4 gv = acc[ai][bj][m][n];
                    float o[4];
#pragma unroll
                    for (int j = 0; j < 4; ++j) { const float g = gv[j];
                        float g1 = dpp_row_shr<1>(h1[j], g), g2 = dpp_row_shr<2>(h2[j], g), g3 = dpp_row_shr<3>(h3[j], g);
                        g1 = p >= 1 ? g1 : 0.f; g2 = p >= 2 ? g2 : 0.f; g3 = p >= 3 ? g3 : 0.f;
                        const float v = bs[j] + w3[j] * g + w2[j] * g1 + w1[j] * g2 + w0[j] * g3;
                        o[j] = v * __builtin_amdgcn_rcpf(1.f + ex2(-1.4426950408889634f * v)); }
                    if (ok) { u32x2 w; w.x = pk2e(o[0], o[1]); w.y = pk2e(o[2], o[3]); *(u32x2*)((char*)O + ooff + co * 2) = w; }
                    asm volatile("" ::: "memory"); }
            }
    }
};
struct EpiUpConv {
    static constexpr bool PERM = true;
    bf16_t* ACT; const float* cw; const float* cb;
    __device__ __forceinline__ void operator()(const f32x4 (&acc)[2][2][4][2], const Unit& u, int wr, int wc, int fr, int fq, LAS unsigned char* hb) const {
        constexpr int H = 2, NCH = 128;
        int chl = wc * 32 + 8 * fq; asm volatile("" : "+v"(chl), "+v"(fr));
        const int R0 = 254 * u.pm - 2; const int ch = u.pn * HALF + chl;
        if (fr >= 16 - H) {
#pragma unroll
            for (int ai = 0; ai < 2; ++ai)
#pragma unroll
                for (int m = 0; m < 4; ++m) { const int q = 8 * ai + 4 * wr + m;
                    LAS f32x4* hw = (LAS f32x4*)(hb + ((q * H + fr - (16 - H)) * NCH + chl) * 4); hw[0] = acc[ai][0][m][0]; hw[1] = acc[ai][0][m][1]; }
        }
        asm volatile("s_waitcnt lgkmcnt(0)" ::: "memory"); __builtin_amdgcn_s_barrier(); asm volatile("" ::: "memory");
        const int hr1 = H - 1, hr2 = (H - 2 + fr) < (H - 1) ? (H - 2 + fr) : (H - 1);
#pragma unroll
        for (int n = 0; n < 2; ++n) { asm volatile("" ::: "memory");
            const int c4 = ch + 4 * n;
            const f32x4 w0 = *(const f32x4*)(cw + 0 * DFF + c4), w1 = *(const f32x4*)(cw + 1 * DFF + c4), w2 = *(const f32x4*)(cw + 2 * DFF + c4), bs = *(const f32x4*)(cb + c4);
#pragma unroll
            for (int ai = 0; ai < 2; ++ai)
#pragma unroll
                for (int m = 0; m < 4; ++m) { const int q = 8 * ai + 4 * wr + m, prev = q > 0 ? q - 1 : 0; const int lr = ai * HALF + wr * 64 + m * 16 + fr, R = R0 + lr;
                    const int Rc = R < 0 ? 0 : R; const int b = Rc / LL, p = Rc - b * LL;
                    const LAS unsigned char* hp = hb + (prev * H * NCH + chl + 4 * n) * 4;
                    const f32x4 h1 = *(const LAS f32x4*)(hp + hr1 * NCH * 4), h2 = *(const LAS f32x4*)(hp + hr2 * NCH * 4);
                    const f32x4 gv = acc[ai][0][m][n], uv = acc[ai][1][m][n];
                    float o[4];
#pragma unroll
                    for (int j = 0; j < 4; ++j) { const float g = gv[j];
                        float g1 = dpp_row_shr<1>(h1[j], g), g2 = dpp_row_shr<2>(h2[j], g);
                        g1 = p >= 1 ? g1 : 0.f; g2 = p >= 2 ? g2 : 0.f;
                        const float v = bs[j] + w2[j] * g + w1[j] * g1 + w0[j] * g2;
                        const float a = v + 0.044715f * v * v * v;
                        const float ge = v * __builtin_amdgcn_rcpf(1.f + ex2(-2.f * 0.7978845608028654f * 1.4426950408889634f * a));
                        o[j] = ge * uv[j]; }
                    if (lr >= H && R < TT && p >= NMETA) { u32x2 w; w.x = pk2e(o[0], o[1]); w.y = pk2e(o[2], o[3]);
                        *(u32x2*)(ACT + ((size_t)b * SEQ + p - NMETA) * DFF + c4) = w; } }
        }
    }
};

template <class Epi, class Sched, bool ALIGN_EPI = true>
__device__ __forceinline__ void gemm_phase(LAS unsigned char* lds, const Gemm g, const Sched& S, const Epi& E) {
    int tid_ = threadIdx.x; asm volatile("" : "+v"(tid_));
    const int tid = tid_, wid = __builtin_amdgcn_readfirstlane(tid >> 6), lane = tid & 63, wr = wid >> 2, wc = wid & 3, fr = lane & 15, fq = lane >> 4;
    const int K = g.K, nt = K / BK;
    unsigned voffA[2], voffB[2];
#pragma unroll
    for (int i = 0; i < 2; ++i) { int R, C; stage_rc(tid * 16 + i * 8192, R, C); const int Rb = Epi::PERM ? ((R & ~31) + perm32(R & 31)) : R;
        voffA[i] = (unsigned)(R * g.lda + C) * 2u; voffB[i] = (unsigned)(Rb * g.ldb + C) * 2u; }
    const size_t kstep = (size_t)(BK * 2);
    const size_t hsA = (size_t)HALF * g.lda * 2, hsB = (size_t)HALF * g.ldb * 2;
    const size_t tsB = 2 * hsB;
    const unsigned ldsw = (unsigned)wid * 1024u;
    const int aoff = lds_byte(wr * 64 + fr, fq * 8), boff = lds_byte(wc * 32 + fr, fq * 8);
#define PG8_SA(b, h) (((b) * 2 + (h)) * HTB)
#define PG8_SB(b, h) ((4 + (b) * 2 + (h)) * HTB)
#define PG8_STAGE(bufoff, gbase, voff) do { _Pragma("unroll") for (int _i = 0; _i < 2; ++_i) \
        __builtin_amdgcn_global_load_lds((const unsigned*)((const char*)(gbase) + (voff)[_i]), (LAS unsigned*)(lds + (bufoff) + ldsw + _i * 8192), 16, 0, 0); } while (0)
#define PG8_LDA(dst, b, h) do { _Pragma("unroll") for (int m = 0; m < 4; ++m) _Pragma("unroll") for (int k = 0; k < 2; ++k) dst[m][k] = *(const LAS bf16x8*)(lds + PG8_SA(b, h) + aoff + m * 2048 + k * 1024); } while (0)
#define PG8_LDB(dst, b, h) do { _Pragma("unroll") for (int n = 0; n < 2; ++n) _Pragma("unroll") for (int k = 0; k < 2; ++k) dst[n][k] = *(const LAS bf16x8*)(lds + PG8_SB(b, h) + boff + n * 2048 + k * 1024); } while (0)
#define PG8_MMA(ai, bj, At, Bt) do { __builtin_amdgcn_s_setprio(1); _Pragma("unroll") for (int m = 0; m < 4; ++m) _Pragma("unroll") for (int n = 0; n < 2; ++n) _Pragma("unroll") for (int k = 0; k < 2; ++k) \
        acc[ai][bj][m][n] = __builtin_amdgcn_mfma_f32_16x16x32_bf16(Bt[n][k], At[m][k], acc[ai][bj][m][n], 0, 0, 0); __builtin_amdgcn_s_setprio(0); } while (0)
#define PG8_WAIT_V(n) asm volatile("s_waitcnt vmcnt(" #n ")" ::: "memory")
#define PG8_WAIT_L(n) asm volatile("s_waitcnt lgkmcnt(" #n ")" ::: "memory")
#define PG8_BAR __builtin_amdgcn_s_barrier()
#define PG8_SCHED __builtin_amdgcn_sched_barrier(0)
    Unit cur, nxt; int ui = 0;
    if (!S.next(0, cur)) return;
    f32x4 acc[2][2][4][2];
#pragma unroll
    for (int a = 0; a < 2; ++a)
#pragma unroll
        for (int b = 0; b < 2; ++b)
#pragma unroll
            for (int m = 0; m < 4; ++m)
#pragma unroll
                for (int n = 0; n < 2; ++n) acc[a][b][m][n] = (f32x4){0.f, 0.f, 0.f, 0.f};
    bf16x8 At[4][2], B0[2][2], B1[2][2];
    const char* cA = (const char*)g.A + ((long)cur.pm * g.mstride + g.moff) * (long)(g.lda * 2); const char* cB = (const char*)g.Bt + (size_t)cur.pn * tsB;
    PG8_STAGE(PG8_SB(0, 0), cB, voffB); PG8_STAGE(PG8_SB(0, 1), cB + hsB, voffB); PG8_STAGE(PG8_SA(0, 0), cA, voffA); PG8_STAGE(PG8_SA(0, 1), cA + hsA, voffA);
    if (wr == 1) PG8_BAR;
    PG8_WAIT_V(2); PG8_BAR;
    PG8_STAGE(PG8_SB(1, 0), cB + kstep, voffB); PG8_STAGE(PG8_SA(1, 0), cA + kstep, voffA); PG8_STAGE(PG8_SB(1, 1), cB + hsB + kstep, voffB);
    PG8_WAIT_V(6); PG8_BAR;
    for (;;) {
        const bool has_next = S.next(ui + 1, nxt);
        const char* nA = has_next ? (const char*)g.A + ((long)nxt.pm * g.mstride + g.moff) * (long)(g.lda * 2) : cA; const char* nB = has_next ? (const char*)g.Bt + (size_t)nxt.pn * tsB : cB;
        for (int t = 0; t < nt; t += 2) {
            const bool last = (t == nt - 2);
            const char* a1 = cA + (size_t)(t + 1) * kstep;
            const char* a2 = last ? nA : cA + (size_t)(t + 2) * kstep; const char* b2 = last ? nB : cB + (size_t)(t + 2) * kstep;
            const char* a3 = a2 + kstep; const char* b3 = b2 + kstep;
            PG8_LDB(B0, 0, 0); PG8_LDB(B1, 0, 1); PG8_SCHED; PG8_LDA(At, 0, 0); PG8_STAGE(PG8_SA(1, 1), a1 + hsA, voffA);
            PG8_WAIT_V(8); PG8_WAIT_L(0); PG8_BAR; PG8_MMA(0, 0, At, B0); PG8_MMA(0, 1, At, B1); PG8_BAR; PG8_SCHED;
            PG8_LDA(At, 0, 1); PG8_STAGE(PG8_SB(0, 0), b2, voffB); PG8_STAGE(PG8_SB(0, 1), b2 + hsB, voffB); PG8_STAGE(PG8_SA(0, 0), a2, voffA);
            PG8_WAIT_V(8); PG8_WAIT_L(0); PG8_BAR; PG8_MMA(1, 0, At, B0); PG8_MMA(1, 1, At, B1); PG8_BAR; PG8_SCHED;
            PG8_LDB(B0, 1, 0); PG8_LDB(B1, 1, 1); PG8_SCHED; PG8_LDA(At, 1, 0); PG8_STAGE(PG8_SA(0, 1), a2 + hsA, voffA);
            PG8_WAIT_V(8); PG8_WAIT_L(0); PG8_BAR; PG8_MMA(0, 0, At, B0); PG8_MMA(0, 1, At, B1); PG8_BAR; PG8_SCHED;
            PG8_LDA(At, 1, 1); PG8_STAGE(PG8_SB(1, 0), b3, voffB); PG8_STAGE(PG8_SB(1, 1), b3 + hsB, voffB); PG8_STAGE(PG8_SA(1, 0), a3, voffA);
            PG8_WAIT_V(8); PG8_WAIT_L(0); PG8_BAR; PG8_MMA(1, 0, At, B0); PG8_MMA(1, 1, At, B1); PG8_BAR; PG8_SCHED;
        }
        if constexpr (ALIGN_EPI) { if (wr == 0) PG8_BAR; }
        E(acc, cur, wr, wc, fr, fq, lds + STAGE_BYTES);
        if (!has_next) break;
#pragma unroll
        for (int a = 0; a < 2; ++a)
#pragma unroll
            for (int b = 0; b < 2; ++b)
#pragma unroll
                for (int m = 0; m < 4; ++m)
#pragma unroll
                    for (int n = 0; n < 2; ++n) acc[a][b][m][n] = (f32x4){0.f, 0.f, 0.f, 0.f};
        cur = nxt; cA = nA; cB = nB; ++ui;
        if constexpr (ALIGN_EPI) { if (wr == 1) PG8_BAR; }
    }
    PG8_WAIT_V(0);
    if constexpr (!ALIGN_EPI) { if (wr == 0) PG8_BAR; }
    PG8_BAR;
#undef PG8_SA
#undef PG8_SB
#undef PG8_STAGE
#undef PG8_LDA
#undef PG8_LDB
#undef PG8_MMA
#undef PG8_WAIT_V
#undef PG8_WAIT_L
#undef PG8_BAR
#undef PG8_SCHED
}
}

#define LDS_WAIT() asm volatile("s_waitcnt lgkmcnt(0)" ::: "memory")
typedef __bf16 bf16v2 __attribute__((ext_vector_type(2)));
__device__ __forceinline__ unsigned pk2(float lo, float hi) { bf16v2 v; v.x = (__bf16)lo; v.y = (__bf16)hi; return __builtin_bit_cast(unsigned, v); }
__device__ __forceinline__ unsigned f2bf(float f) { return pk2(f, 0.f) & 0xffffu; }
__device__ __forceinline__ float bf2f(unsigned short h) { return __builtin_bit_cast(float, (unsigned)h << 16); }
__device__ __forceinline__ float bflo(unsigned w) { return __builtin_bit_cast(float, w << 16); }
__device__ __forceinline__ float bfhi(unsigned w) { return __builtin_bit_cast(float, w & 0xffff0000u); }
__device__ __forceinline__ float wave_sum(float v) {
#pragma unroll
    for (int o = 1; o < 64; o <<= 1) v += __shfl_xor(v, o);
    return v;
}
template <int CTRL, int ROWMASK> __device__ __forceinline__ float dppf(float v) {
    return __builtin_bit_cast(float, __builtin_amdgcn_update_dpp(0, __builtin_bit_cast(int, v), CTRL, ROWMASK, 0xf, true)); }
__device__ __forceinline__ int crow(int r, int hi) { return (r & 3) + 8 * (r >> 2) + 4 * hi; }
__device__ __forceinline__ float fexp(float x) { return __builtin_amdgcn_exp2f(x * 1.4426950408889634f); }
__device__ __forceinline__ float silu(float v) { return v * __builtin_amdgcn_rcpf(1.f + fexp(-v)); }

struct Params {
    const float* x; const float* meta; const float* mix_pre_g; const float* w_in; const float* conv_w; const float* conv_b; const float* dt_bias;
    const float* a_log; const float* d_skip; const float* ssd_norm_g; const float* sb_norm_g; const float* w_out; const float* mix_post_g; const float* ffn_pre_g;
    const float* w_up; const float* fconv_w; const float* fconv_b; const float* w_down; const float* ffn_post_g;
    float* out; unsigned char* ws;
};

__device__ __forceinline__ void p0_transpose_item(const float* W, int K, int N, bf16_t* WT, LAS float* scr, int kb, int sn0, int dn0, int lane) {
    const int k0 = 64 * kb;
    const int n4 = 4 * (lane & 7), nn = sn0 + n4;
    f32x4 wv[8];
#pragma unroll
    for (int i = 0; i < 8; ++i) { const int kk = 8 * i + (lane >> 3); wv[i] = (nn < N) ? __builtin_nontemporal_load((const f32x4*)(W + (size_t)(k0 + kk) * N + nn)) : (f32x4){0.f, 0.f, 0.f, 0.f}; }
#pragma unroll
    for (int i = 0; i < 8; ++i) { const int kk = 8 * i + (lane >> 3); LAS float* d = scr + kk * 33 + n4; d[0] = wv[i].x; d[1] = wv[i].y; d[2] = wv[i].z; d[3] = wv[i].w; }
    LDS_WAIT(); asm volatile("" ::: "memory");
    const int c = lane & 7;
#pragma unroll
    for (int j = 0; j < 4; ++j) { const int n = (lane >> 3) + 8 * j; const LAS float* s = scr + (8 * c) * 33 + n;
        u32x4 o; o.x = pk2(s[0 * 33], s[1 * 33]); o.y = pk2(s[2 * 33], s[3 * 33]); o.z = pk2(s[4 * 33], s[5 * 33]); o.w = pk2(s[6 * 33], s[7 * 33]);
        *(u32x4*)(WT + (size_t)(dn0 + n) * K + k0 + 8 * c) = o; }
    LDS_WAIT(); asm volatile("" ::: "memory");
}

__device__ __forceinline__ void rms_store_bf16(const f32x4 (&v)[4], const float* g, bf16_t* orow, int lane) {
    float s = 0.f;
#pragma unroll
    for (int j = 0; j < 4; ++j) s += (v[j].x * v[j].x + v[j].y * v[j].y) + (v[j].z * v[j].z + v[j].w * v[j].w);
    const float rs = 1.f / sqrtf(wave_sum(s) * (1.f / 1024.f) + EPS);
    unsigned long long* o8 = (unsigned long long*)orow + lane;
#pragma unroll
    for (int j = 0; j < 4; ++j) { const f32x4 gg = *((const f32x4*)g + lane + 64 * j);
        o8[64 * j] = (unsigned long long)pk2(v[j].x * rs * gg.x, v[j].y * rs * gg.y) | ((unsigned long long)pk2(v[j].z * rs * gg.z, v[j].w * rs * gg.w) << 32); }
}
__device__ __forceinline__ void zero_row_bf16(bf16_t* orow, int ncol, int lane) {
    unsigned long long* o8 = (unsigned long long*)orow;
    for (int i = lane; i < ncol / 4; i += 64) o8[i] = 0ull;
}

constexpr int LP = 272;
template <int KS>
__device__ __forceinline__ f32x16 mma_nt(const LAS unsigned char* A, const LAS unsigned char* B, f32x16 acc, int lane) {
    const LAS unsigned char* ap = A + (lane & 31) * LP + (lane >> 5) * 16;
    const LAS unsigned char* bp = B + (lane & 31) * LP + (lane >> 5) * 16;
    bf16x8 a[KS], b[KS];
#pragma unroll
    for (int ks = 0; ks < KS; ++ks) { a[ks] = *(const LAS bf16x8*)(ap + ks * 32); b[ks] = *(const LAS bf16x8*)(bp + ks * 32); }
    __builtin_amdgcn_sched_barrier(0);
#pragma unroll
    for (int ks = 0; ks < KS; ++ks) acc = __builtin_amdgcn_mfma_f32_32x32x16_bf16(a[ks], b[ks], acc, 0, 0, 0);
    return acc;
}

constexpr int S_CC = 0, S_BC = 34816, S_MM = 69632, S_XDTT = 104448, S_XDDT = 121856, S_SB = 139264, S_ACS = 156672, S_DTV = 157696;
__device__ __forceinline__ void ssd_item(const Params& P, LAS unsigned char* lds, int item, int tid, int wave, int lane) {
    const int b = item >> 4, h = item & 15, g = h >> 3;
    const bf16_t* PROJ = (const bf16_t*)(P.ws + WS_PROJ); bf16_t* YS = (bf16_t*)(P.ws + WS_YSSD);
    const float dtb = P.dt_bias[h];
    const float Ah = -__expf(P.a_log[h]), Dh = P.d_skip[h];
    const int r = lane & 31, hh = lane >> 5;
    const int xrow0 = tid >> 3, xoct = tid & 7;
    const int brow0 = tid >> 5, bsel = (tid >> 4) & 1, boct = tid & 15;
    const int yb = wave & 3, pb = wave >> 2;
    const int ycol = h * 64 + pb * 32 + r;
    const __amdgpu_buffer_rsrc_t prs = __builtin_amdgcn_make_buffer_rsrc((void*)PROJ, 0, 0x7fffffff, 0x00020000);
    const __amdgpu_buffer_rsrc_t yrs = __builtin_amdgcn_make_buffer_rsrc((void*)YS, 0, 0x7fffffff, 0x00020000);
    const int yc = lane & 15, yg = lane >> 4;
    const unsigned zvoff = (unsigned)(4 * yg * LDP + OFF_Z + h * 64 + 4 * yc) * 2u, xvoff = (unsigned)(4 * yg * LDP + OFF_XBC + h * 64 + 4 * yc) * 2u, yvoff = (unsigned)(4 * yg * 1024 + h * 64 + 4 * yc) * 2u;
    f32x16 sacc; for (int i = 0; i < 16; ++i) sacc[i] = 0.f;
    for (int i = tid; i < 64 * LP / 4; i += NTHR) ((LAS unsigned*)(lds + S_SB))[i] = 0u;
    const size_t rowbase = (size_t)b * LL;
    u32x4 pbc[8], pxv[2]; unsigned pd0 = 0u, pd1 = 0u;
#define SSD_LOAD(cc) do { const int _p0 = 128 * (cc); const int _nv = (LL - _p0) < 128 ? (LL - _p0) : 128; \
        _Pragma("unroll") for (int k = 0; k < 8; ++k) { int _br = brow0 + 16 * k; _br = _br < _nv ? _br : _nv - 1;        \
            pbc[k] = *(const u32x4*)(PROJ + (rowbase + _p0 + _br) * LDP + OFF_XBC + 1024 + bsel * 256 + g * 128 + boct * 8); } \
        _Pragma("unroll") for (int q = 0; q < 2; ++q) { int _xr = xrow0 + 64 * q; _xr = _xr < _nv ? _xr : _nv - 1;        \
            pxv[q] = __builtin_nontemporal_load((const u32x4*)(PROJ + (rowbase + _p0 + _xr) * LDP + OFF_XBC + h * 64 + xoct * 8)); } \
        if (wave == 7) { const int _r0 = (2 * lane) < _nv ? 2 * lane : _nv - 1, _r1 = (2 * lane + 1) < _nv ? 2 * lane + 1 : _nv - 1; \
            pd0 = (unsigned)PROJ[(rowbase + _p0 + _r0) * LDP + OFF_DT + h]; pd1 = (unsigned)PROJ[(rowbase + _p0 + _r1) * LDP + OFF_DT + h]; } } while (0)
#define SSD_SCAN(cc) do { const int _nv = (LL - 128 * (cc)) < 128 ? (LL - 128 * (cc)) : 128; \
        LAS float* _acs = (LAS float*)(lds + S_ACS) + ((cc) & 1) * 128; LAS float* _dtv = (LAS float*)(lds + S_DTV) + ((cc) & 1) * 128; \
        const int r0 = 2 * lane, r1 = r0 + 1; const float v0 = bf2f((unsigned short)pd0) + dtb, v1 = bf2f((unsigned short)pd1) + dtb; \
        const float sp0 = fmaxf(v0, 0.f) + 0.6931471805599453f * __builtin_amdgcn_logf(1.f + __builtin_amdgcn_exp2f(-1.4426950408889634f * fabsf(v0))); \
        const float sp1 = fmaxf(v1, 0.f) + 0.6931471805599453f * __builtin_amdgcn_logf(1.f + __builtin_amdgcn_exp2f(-1.4426950408889634f * fabsf(v1))); \
        const float d0 = (r0 < _nv) ? sp0 : 0.f, d1 = (r1 < _nv) ? sp1 : 0.f; \
        const float a0 = d0 * Ah, a1 = d1 * Ah; float s = a0 + a1, inc = s; \
        inc += dppf<0x111, 0xf>(inc); inc += dppf<0x112, 0xf>(inc); inc += dppf<0x114, 0xf>(inc); inc += dppf<0x118, 0xf>(inc);     \
        inc += dppf<0x142, 0xa>(inc); inc += dppf<0x143, 0xc>(inc);                                                                  \
        const float ex = inc - s; \
        _acs[r0] = ex + a0; _acs[r1] = ex + a0 + a1; _dtv[r0] = d0; _dtv[r1] = d1; } while (0)
    SSD_LOAD(0);
    if (wave == 7) SSD_SCAN(0);
    asm volatile("" :: "v"(pbc[0]), "v"(pbc[1]), "v"(pbc[2]), "v"(pbc[3]), "v"(pbc[4]), "v"(pbc[5]), "v"(pbc[6]), "v"(pbc[7]), "v"(pxv[0]), "v"(pxv[1]));
    __syncthreads();
    for (int c = 0; c < 33; ++c) {
        const int p0 = 128 * c, nvalid = (LL - p0) < 128 ? (LL - p0) : 128;
        LAS float* ACS = (LAS float*)(lds + S_ACS) + (c & 1) * 128; LAS float* DTV = (LAS float*)(lds + S_DTV) + (c & 1) * 128;
#pragma unroll
        for (int k = 0; k < 8; ++k) { const int br = brow0 + 16 * k;
            u32x4 v = pbc[k]; if (br >= nvalid) v = (u32x4){0u, 0u, 0u, 0u};
            *(LAS u32x4*)(lds + (bsel ? S_CC : S_BC) + br * LP + boct * 16) = v; }
        {
            const float aend = ACS[127];
#pragma unroll
            for (int q = 0; q < 2; ++q) { const int s = xrow0 + 64 * q; const bool sv = s < nvalid;
                const float dtv = DTV[s], dd = fexp(aend - ACS[s]);
                const unsigned w4[4] = {pxv[q].x, pxv[q].y, pxv[q].z, pxv[q].w};
                const int sofs = (((s >> 3) ^ xoct) << 4) + (s & 7) * 2;
#pragma unroll
                for (int j = 0; j < 8; ++j) { float x = (j & 1) ? bfhi(w4[j >> 1]) : bflo(w4[j >> 1]); x = sv ? x : 0.f; const int p = xoct * 8 + j;
                    const float xd = x * dtv;
                    *(LAS unsigned short*)(lds + S_XDTT + p * LP + sofs) = (unsigned short)f2bf(xd);
                    *(LAS unsigned short*)(lds + S_XDDT + p * LP + sofs) = (unsigned short)f2bf(xd * dd); } }
        }
        __syncthreads();
        u32x2 zc[4], xc[4];
        {
            const int zb = __builtin_amdgcn_readfirstlane((int)(((unsigned)rowbase + p0 + wave * 16) * LDP * 2u));
#pragma unroll
            for (int i = 0; i < 4; ++i) { zc[i] = __builtin_bit_cast(u32x2, __builtin_amdgcn_raw_buffer_load_b64(prs, zvoff, zb + i * (LDP * 2), 2));
                                          xc[i] = __builtin_bit_cast(u32x2, __builtin_amdgcn_raw_buffer_load_b64(prs, xvoff, zb + i * (LDP * 2), 2)); }
        }
        if (c + 1 < 33) SSD_LOAD(c + 1);
        const int lb = wave >> 1, sb0 = 2 * (wave & 1);
        f32x16 g0, g1; for (int i = 0; i < 16; ++i) { g0[i] = 0.f; g1[i] = 0.f; }
        if (sb0 <= lb) g0 = mma_nt<4>(lds + S_CC + lb * 32 * LP + 128, lds + S_BC + sb0 * 32 * LP + 128, mma_nt<4>(lds + S_CC + lb * 32 * LP, lds + S_BC + sb0 * 32 * LP, g0, lane), lane);
        if (sb0 + 1 <= lb) g1 = mma_nt<4>(lds + S_CC + lb * 32 * LP + 128, lds + S_BC + (sb0 + 1) * 32 * LP + 128, mma_nt<4>(lds + S_CC + lb * 32 * LP, lds + S_BC + (sb0 + 1) * 32 * LP, g1, lane), lane);
        float al[16];
#pragma unroll
        for (int i = 0; i < 16; ++i) al[i] = ACS[lb * 32 + crow(i, hh)];
        {
            const float ref = ACS[lb > 0 ? lb * 32 - 1 : 0];
            float ul[16];
#pragma unroll
            for (int i = 0; i < 16; ++i) ul[i] = fexp(fminf(al[i] - ref, 0.f));
            if (sb0 <= lb) { const int s = sb0 * 32 + r; const float as = ACS[s];
                if (sb0 < lb) { const float vs = fexp(fminf(ref - as, 0.f));
#pragma unroll
                    for (int i = 0; i < 16; ++i) { const int l = lb * 32 + crow(i, hh); *(LAS unsigned short*)(lds + S_MM + l * LP + s * 2) = (unsigned short)f2bf(g0[i] * (ul[i] * vs)); }
                } else {
#pragma unroll
                    for (int i = 0; i < 16; ++i) { const int l = lb * 32 + crow(i, hh); const float e = fexp(fminf(al[i] - as, 0.f)); const float val = (s <= l) ? g0[i] * e : 0.f;
                        *(LAS unsigned short*)(lds + S_MM + l * LP + s * 2) = (unsigned short)f2bf(val); } } }
            if (sb0 + 1 <= lb) { const int s = (sb0 + 1) * 32 + r; const float as = ACS[s];
                if (sb0 + 1 < lb) { const float vs = fexp(fminf(ref - as, 0.f));
#pragma unroll
                    for (int i = 0; i < 16; ++i) { const int l = lb * 32 + crow(i, hh); *(LAS unsigned short*)(lds + S_MM + l * LP + s * 2) = (unsigned short)f2bf(g1[i] * (ul[i] * vs)); }
                } else {
#pragma unroll
                    for (int i = 0; i < 16; ++i) { const int l = lb * 32 + crow(i, hh); const float e = fexp(fminf(al[i] - as, 0.f)); const float val = (s <= l) ? g1[i] * e : 0.f;
                        *(LAS unsigned short*)(lds + S_MM + l * LP + s * 2) = (unsigned short)f2bf(val); } } }
        }
        {
            const float cd = fexp(ACS[127]);
#pragma unroll
            for (int i = 0; i < 16; ++i) sacc[i] *= cd;
            {
                const LAS unsigned char* ap = lds + S_XDDT + (pb * 32 + r) * LP; const int xsw = ((pb * 32 + r) >> 3) & 7;
                const LAS unsigned char* bp = lds + S_BC + (8 * hh) * LP + (yb * 32 + r) * 2;
#pragma unroll
                for (int kh = 0; kh < 2; ++kh) {
                    bf16x8 af[4], bfr[4];
#pragma unroll
                    for (int k4 = 0; k4 < 4; ++k4) { const int ks = kh * 4 + k4; af[k4] = *(const LAS bf16x8*)(ap + (((2 * ks + hh) ^ xsw) << 4));
#pragma unroll
                        for (int j = 0; j < 8; ++j) bfr[k4][j] = *(const LAS short*)(bp + (16 * ks + j) * LP); }
                    __builtin_amdgcn_sched_barrier(0);
#pragma unroll
                    for (int k4 = 0; k4 < 4; ++k4) sacc = __builtin_amdgcn_mfma_f32_32x32x16_bf16(af[k4], bfr[k4], sacc, 0, 0, 0);
                }
            }
        }
        __syncthreads();
        asm volatile("" :: "v"(pbc[0]), "v"(pbc[1]), "v"(pbc[2]), "v"(pbc[3]), "v"(pbc[4]), "v"(pbc[5]), "v"(pbc[6]), "v"(pbc[7]), "v"(pxv[0]), "v"(pxv[1]), "v"(pd0), "v"(pd1));
        {
            f32x4 ya[4];
#pragma unroll
            for (int q = 0; q < 4; ++q) ya[q] = (f32x4){0.f, 0.f, 0.f, 0.f};
            const LAS unsigned char* cap = lds + S_CC + (wave * 16 + yc) * LP + yg * 16;
            {
                bf16x8 af[4];
#pragma unroll
                for (int ks = 0; ks < 4; ++ks) af[ks] = *(const LAS bf16x8*)(cap + ks * 64);
#pragma unroll
                for (int q = 0; q < 4; ++q) { const LAS unsigned char* sbp = lds + S_SB + (4 * yc + q) * LP + yg * 16;
                    bf16x8 bfr[4];
#pragma unroll
                    for (int ks = 0; ks < 4; ++ks) bfr[ks] = *(const LAS bf16x8*)(sbp + ks * 64);
#pragma unroll
                    for (int ks = 0; ks < 4; ++ks) ya[q] = __builtin_amdgcn_mfma_f32_16x16x32_bf16(af[ks], bfr[ks], ya[q], 0, 0, 0); }
            }
            float ay[4];
#pragma unroll
            for (int i = 0; i < 4; ++i) ay[i] = fexp(ACS[wave * 16 + 4 * yg + i]);
#pragma unroll
            for (int q = 0; q < 4; ++q) { ya[q][0] *= ay[0]; ya[q][1] *= ay[1]; ya[q][2] *= ay[2]; ya[q][3] *= ay[3]; }
            {
                const LAS unsigned char* map = lds + S_MM + (wave * 16 + yc) * LP + yg * 16;
                const int nks = (wave >> 1) + 1;
                for (int ks = 0; ks < nks; ++ks) {
                    const bf16x8 am = *(const LAS bf16x8*)(map + ks * 64);
#pragma unroll
                    for (int q = 0; q < 4; ++q) { const int p = 4 * yc + q; const int xsw = (p >> 3) & 7;
                        const bf16x8 bx = *(const LAS bf16x8*)(lds + S_XDTT + p * LP + (((4 * ks + yg) ^ xsw) << 4));
                        ya[q] = __builtin_amdgcn_mfma_f32_16x16x32_bf16(am, bx, ya[q], 0, 0, 0); }
                }
            }
            u32x2 yo[4];
#pragma unroll
            for (int i = 0; i < 4; ++i) {
                const float z0 = bflo(zc[i].x), z1 = bfhi(zc[i].x), z2 = bflo(zc[i].y), z3 = bfhi(zc[i].y);
                const float x0 = bflo(xc[i].x), x1 = bfhi(xc[i].x), x2 = bflo(xc[i].y), x3 = bfhi(xc[i].y);
                yo[i].x = pk2((ya[0][i] + Dh * x0) * silu(z0), (ya[1][i] + Dh * x1) * silu(z1));
                yo[i].y = pk2((ya[2][i] + Dh * x2) * silu(z2), (ya[3][i] + Dh * x3) * silu(z3)); }
            __builtin_amdgcn_sched_barrier(0);
            const int yb0 = __builtin_amdgcn_readfirstlane((int)(((unsigned)rowbase + p0 + wave * 16) * 1024u * 2u));
            if (nvalid == 128) {
#pragma unroll
                for (int i = 0; i < 4; ++i) __builtin_amdgcn_raw_buffer_store_b64(__builtin_bit_cast(__attribute__((__vector_size__(2 * sizeof(unsigned)))) unsigned, yo[i]), yrs, yvoff, yb0 + i * 2048, 0);
            } else {
#pragma unroll
                for (int i = 0; i < 4; ++i) if (wave * 16 + 4 * yg + i < nvalid) __builtin_amdgcn_raw_buffer_store_b64(__builtin_bit_cast(__attribute__((__vector_size__(2 * sizeof(unsigned)))) unsigned, yo[i]), yrs, yvoff, yb0 + i * 2048, 0);
            }
        }
        if (wave == 7 && c + 1 < 33) SSD_SCAN(c + 1);
        __syncthreads();
#pragma unroll
        for (int i = 0; i < 16; ++i) *(LAS unsigned short*)(lds + S_SB + (pb * 32 + crow(i, hh)) * LP + (yb * 32 + r) * 2) = (unsigned short)f2bf(sacc[i]);
    }
#undef SSD_LOAD
#undef SSD_SCAN
    __syncthreads();
}

__device__ __forceinline__ void attn_item(const Params& P, int qi, int bh, int lane) {
    const int hd = bh & 15, b = bh >> 4;
    const bf16_t* PROJ = (const bf16_t*)(P.ws + WS_PROJ); bf16_t* OSB = (bf16_t*)P.out;
    const int r = lane & 31, hh = lane >> 5, t0 = 32 * qi, tq = t0 + r;
    const bool qvalid = tq < LL; const int tql = qvalid ? tq : LL - 1;
    const size_t rowbase = (size_t)b * LL;
    const bf16_t* qrow = PROJ + (rowbase + tql) * LDP + OFF_Q + hd * 64 + 8 * hh;
    bf16x8 qf[4];
#pragma unroll
    for (int ks = 0; ks < 4; ++ks) qf[ks] = __builtin_nontemporal_load((const bf16x8*)(qrow + 16 * ks));
    f32x16 o0, o1; for (int i = 0; i < 16; ++i) { o0[i] = 0.f; o1[i] = 0.f; }
    float run = 0.f;
    const float C2 = 0.125f * 1.4426950408889634f;
    bf16x8 kf[4], nkf[4], vb[4], nvb[4];
    const __amdgpu_buffer_rsrc_t prs = __builtin_amdgcn_make_buffer_rsrc((void*)PROJ, 0, 0x7fffffff, 0x00020000);
    const unsigned koff = (unsigned)(r * LDP + 8 * hh) * 2u, voff = (unsigned)(4 * hh * LDP + 2 * r) * 2u;
    const int kbase = (int)(((unsigned)rowbase * LDP + OFF_K + hd * 64) * 2u), vbase = (int)(((unsigned)rowbase * LDP + OFF_V + hd * 64) * 2u);
#define ATT_LOAD(KF, VB, kt_) do { const int _kt = __builtin_amdgcn_readfirstlane(kbase + 32 * (kt_) * (LDP * 2)), _vt = __builtin_amdgcn_readfirstlane(vbase + 32 * (kt_) * (LDP * 2)); \
        _Pragma("unroll") for (int ks = 0; ks < 4; ++ks) KF[ks] = __builtin_bit_cast(bf16x8, __builtin_amdgcn_raw_buffer_load_b128(prs, koff + 32 * ks, _kt, 0)); \
        _Pragma("unroll") for (int s = 0; s < 2; ++s) { _Pragma("unroll") for (int j = 0; j < 8; ++j) { const int _vr = _vt + (16 * s + 8 * (j >> 2) + (j & 3)) * (LDP * 2); \
            const unsigned _w = __builtin_amdgcn_raw_buffer_load_b32(prs, voff, _vr, 0); VB[2 * s][j] = (short)(_w & 0xffffu); VB[2 * s + 1][j] = (short)(_w >> 16); } } } while (0)
#define ATT_LOAD_CL(KF, VB, kt_) do { const int _s0 = 32 * (kt_); int _sk = _s0 + r; _sk = _sk < LL ? _sk : LL - 1; \
        const bf16_t* _kr = PROJ + (rowbase + _sk) * LDP + OFF_K + hd * 64 + 8 * hh; \
        _Pragma("unroll") for (int ks = 0; ks < 4; ++ks) KF[ks] = *(const bf16x8*)(_kr + 16 * ks); \
        _Pragma("unroll") for (int s = 0; s < 2; ++s) { _Pragma("unroll") for (int j = 0; j < 8; ++j) { int _key = _s0 + 16 * s + 8 * (j >> 2) + 4 * hh + (j & 3); _key = _key < LL ? _key : LL - 1; \
            const unsigned _w = *(const unsigned*)(PROJ + (rowbase + _key) * LDP + OFF_V + hd * 64 + 2 * r); VB[2 * s][j] = (short)(_w & 0xffffu); VB[2 * s + 1][j] = (short)(_w >> 16); } } } while (0)
    if (qi == 128) { ATT_LOAD_CL(kf, vb, qi); } else { ATT_LOAD(kf, vb, qi); }
    for (int kt = qi; kt >= 0; --kt) {
        const int s0 = 32 * kt;
        { const int ktn = kt > 0 ? kt - 1 : 0; ATT_LOAD(nkf, nvb, ktn); }
        f32x16 acc; for (int i = 0; i < 16; ++i) acc[i] = 0.f;
#pragma unroll
        for (int ks = 0; ks < 4; ++ks) acc = __builtin_amdgcn_mfma_f32_32x32x16_bf16(kf[ks], qf[ks], acc, 0, 0, 0);
        float sp[16], lb[16];
#pragma unroll
        for (int i = 0; i < 16; ++i) { const float z2 = acc[i] * C2;
            const float spv = fmaxf(z2, 0.f) + __builtin_amdgcn_logf(1.f + __builtin_amdgcn_exp2f(-fabsf(z2)));
            sp[i] = spv; lb[i] = z2 - spv; }
        if (kt == qi) {
#pragma unroll
            for (int i = 0; i < 16; ++i) { const bool valid = (s0 + crow(i, hh)) < tq; sp[i] = valid ? sp[i] : 0.f; lb[i] = valid ? lb[i] : -1e30f; }
        }
        float gs[4], og[4], tot[4];
#pragma unroll
        for (int gq = 0; gq < 4; ++gq) { gs[gq] = (sp[4 * gq] + sp[4 * gq + 1]) + (sp[4 * gq + 2] + sp[4 * gq + 3]); og[gq] = __shfl_xor(gs[gq], 32); tot[gq] = gs[gq] + og[gq]; }
        float later[4]; later[3] = 0.f; later[2] = tot[3]; later[1] = later[2] + tot[2]; later[0] = later[1] + tot[1];
        const float tile_sum = later[0] + tot[0];
        float w[16];
#pragma unroll
        for (int gq = 0; gq < 4; ++gq) { const float base = run + later[gq] + (hh == 0 ? og[gq] : 0.f);
            const float w3 = base, w2 = w3 + sp[4 * gq + 3], w1 = w2 + sp[4 * gq + 2], w0 = w1 + sp[4 * gq + 1];
            w[4 * gq + 3] = __builtin_amdgcn_exp2f(lb[4 * gq + 3] - w3); w[4 * gq + 2] = __builtin_amdgcn_exp2f(lb[4 * gq + 2] - w2);
            w[4 * gq + 1] = __builtin_amdgcn_exp2f(lb[4 * gq + 1] - w1); w[4 * gq + 0] = __builtin_amdgcn_exp2f(lb[4 * gq + 0] - w0); }
        run += tile_sum;
#pragma unroll
        for (int s = 0; s < 2; ++s) {
            u32x4 pa; pa.x = pk2(w[8 * s], w[8 * s + 1]); pa.y = pk2(w[8 * s + 2], w[8 * s + 3]); pa.z = pk2(w[8 * s + 4], w[8 * s + 5]); pa.w = pk2(w[8 * s + 6], w[8 * s + 7]);
            const bf16x8 af = __builtin_bit_cast(bf16x8, pa);
            o0 = __builtin_amdgcn_mfma_f32_32x32x16_bf16(af, vb[2 * s], o0, 0, 0, 0);
            o1 = __builtin_amdgcn_mfma_f32_32x32x16_bf16(af, vb[2 * s + 1], o1, 0, 0, 0);
        }
        if (__all((!qvalid) || (run >= 127.f))) break;
#pragma unroll
        for (int q = 0; q < 4; ++q) { kf[q] = nkf[q]; vb[q] = nvb[q]; }
    }
#undef ATT_LOAD
#undef ATT_LOAD_CL
#pragma unroll
    for (int i = 0; i < 16; ++i) { const int t = t0 + crow(i, hh);
        if (t < LL) *(unsigned*)(OSB + (rowbase + t) * 1024 + hd * 64 + 2 * r) = pk2(o0[i], o1[i]); }
}

#define XB_TMO      128
#define XB_XCNT(j)  (256  + 64 * (j))
#define XB_XSUB(j)  (1280 + 64 * (j))
#define XB_XGEN(j)  (2304 + 64 * (j))
#define XB_TOP      3328
#define XB_TOPGEN   3392
#define XCD_BAR_WORDS 3456
#define XB_SPIN_CAP (1u << 22)
__device__ __forceinline__ unsigned xb_ld(unsigned* p)              { return __hip_atomic_load(p, __ATOMIC_RELAXED, __HIP_MEMORY_SCOPE_AGENT); }
__device__ __forceinline__ unsigned xb_add(unsigned* p, unsigned v) { return __hip_atomic_fetch_add(p, v, __ATOMIC_RELAXED, __HIP_MEMORY_SCOPE_AGENT); }
__device__ __forceinline__ unsigned xb_xcc_id() { return (unsigned)__builtin_amdgcn_s_getreg((3 << 11) | 20) & 0xFu; }
#define XB_SPIN(cond, bar) do { unsigned _sp = 0; while (cond) { __builtin_amdgcn_s_sleep(4); \
    if ((++_sp & 255u) == 0u) { if (xb_ld(&(bar)[XB_TMO])) break; if (_sp > XB_SPIN_CAP) { atomicAdd(&(bar)[XB_TMO], 1u); break; } } } } while (0)
struct XcdBarrier { unsigned* bar; unsigned x; volatile LAS unsigned* st; };
__device__ __forceinline__ XcdBarrier xcd_barrier_post(unsigned* bar, volatile LAS unsigned* st) {
    XcdBarrier b; b.bar = bar; b.x = xb_xcc_id(); b.st = st;
    if (threadIdx.x == 0) (void)xb_add(&bar[XB_XCNT(b.x)], 1u);
    return b;
}
__device__ __forceinline__ void xcd_barrier_complete(unsigned* bar, unsigned x, unsigned& nloc, unsigned& nx) {
    const unsigned G = gridDim.x * gridDim.y * gridDim.z;
    unsigned sum, cnt, mine, sp = 0u;
    for (;;) {
        sum = 0u; cnt = 0u; mine = 0u;
#pragma unroll
        for (unsigned j = 0; j < 16; ++j) { const unsigned c = xb_ld(&bar[XB_XCNT(j)]); sum += c; cnt += (c > 0u) ? 1u : 0u; mine = (j == x) ? c : mine; }
        if (sum == G) break;
        __builtin_amdgcn_s_sleep(1);
        if ((++sp & 255u) == 0u) { if (xb_ld(&bar[XB_TMO])) break; if (sp > XB_SPIN_CAP) { atomicAdd(&bar[XB_TMO], 1u); break; } }
    }
    nloc = mine > 0u ? mine : 1u; nx = cnt > 0u ? cnt : 1u;
}
__device__ __forceinline__ void xcd_barrier(const XcdBarrier& b) {
    asm volatile("s_waitcnt vmcnt(0)" ::: "memory");
    __syncthreads();
    if (threadIdx.x == 0) {
        unsigned* bar = b.bar;
        __builtin_amdgcn_s_waitcnt(0);
        unsigned nloc = b.st[0], nx = b.st[1];
        if (nloc == 0u) { xcd_barrier_complete(bar, b.x, nloc, nx); b.st[0] = nloc; b.st[1] = nx; }
        const unsigned old = xb_add(&bar[XB_XSUB(b.x)], 1u);
        const unsigned gen = old / nloc;
        if (old + 1u == (gen + 1u) * nloc) {
            __builtin_amdgcn_fence(__ATOMIC_RELEASE, "agent");
            asm volatile("s_waitcnt vmcnt(0)" ::: "memory");
            const unsigned og = xb_add(&bar[XB_TOP], 1u);
            const unsigned tg = og / nx;
            if (og + 1u == (tg + 1u) * nx) xb_add(&bar[XB_TOPGEN], 1u);
            else XB_SPIN(xb_ld(&bar[XB_TOPGEN]) == tg, bar);
            __builtin_amdgcn_fence(__ATOMIC_ACQUIRE, "agent");
            xb_add(&bar[XB_XGEN(b.x)], 1u);
            asm volatile("s_waitcnt vmcnt(0)" ::: "memory");
        } else {
            XB_SPIN(xb_ld(&bar[XB_XGEN(b.x)]) == gen, bar);
            __builtin_amdgcn_fence(__ATOMIC_ACQUIRE, "agent");
            asm volatile("s_waitcnt vmcnt(0)" ::: "memory");
        }
    }
    __syncthreads();
}


__device__ __forceinline__ void thin_outproj(const bf16_t* A  , const bf16_t* Bt, bf16_t* C  , LAS unsigned char* lds, int bid, int G, int wave, int lane) {
    LAS f32x4* red = (LAS f32x4*)lds;
    for (int t2 = bid; t2 < 256; t2 += G) {
        const int tile = 2 * t2 + (wave >> 2), kq = wave & 3, rt = tile >> 6, ct = tile & 63;
        const bf16_t* ap = A + (size_t)(rt * 16 + (lane & 15)) * MIXW + kq * 512 + (lane >> 4) * 8;
        const bf16_t* bp = Bt + (size_t)(ct * 16 + (lane & 15)) * MIXW + kq * 512 + (lane >> 4) * 8;
        f32x4 acc = (f32x4){0.f, 0.f, 0.f, 0.f};
#pragma unroll
        for (int hb = 0; hb < 2; ++hb) {
            bf16x8 a[8], b[8];
#pragma unroll
            for (int k = 0; k < 8; ++k) { a[k] = *(const bf16x8*)(ap + (hb * 8 + k) * 32); b[k] = *(const bf16x8*)(bp + (hb * 8 + k) * 32); }
#pragma unroll
            for (int k = 0; k < 8; ++k) acc = __builtin_amdgcn_mfma_f32_16x16x32_bf16(a[k], b[k], acc, 0, 0, 0);
        }
        red[((wave >> 2) * 4 + kq) * 64 + lane] = acc;
        __syncthreads();
        if (kq == 0) {
            const LAS f32x4* rp = red + (wave >> 2) * 256 + lane;
            const f32x4 s = (rp[0] + rp[64]) + (rp[128] + rp[192]);
#pragma unroll
            for (int j = 0; j < 4; ++j) C[(size_t)(rt * 16 + (lane >> 4) * 4 + j) * 1024 + ct * 16 + (lane & 15)] = (bf16_t)f2bf(s[j]);
        }
        __syncthreads();
    }
}

__global__ void __launch_bounds__(NTHR, 2) hymba_fwd(Params P) {
    extern __shared__ __attribute__((aligned(16))) unsigned char lds_raw[];
    LAS unsigned char* lds = (LAS unsigned char*)lds_raw;
    cg::grid_group grid = cg::this_grid();
    if (threadIdx.x < 16) ((LAS unsigned*)(lds + LDS_MISC))[threadIdx.x] = 0u;
    __syncthreads();
    XcdBarrier xbar = xcd_barrier_post((unsigned*)P.ws, (volatile LAS unsigned*)(lds + LDS_MISC));
    const int tid = threadIdx.x, wave = __builtin_amdgcn_readfirstlane(tid >> 6); int lane = tid & 63;
    const int G = gridDim.x, bid = blockIdx.x;
    const int gw = bid * NWAVES + wave, NGW = G * NWAVES;
    const int gtid = bid * NTHR + tid, NGT = G * NTHR;
    unsigned char* ws = P.ws;
    bf16_t* WUP = (bf16_t*)(ws + WS_WUP); bf16_t* WDN = (bf16_t*)(ws + WS_WDN); bf16_t* WIN = (bf16_t*)(ws + WS_WIN); bf16_t* WOUT = (bf16_t*)(ws + WS_WOUT);
    bf16_t* PROJ = (bf16_t*)(ws + WS_PROJ);
    bf16_t* YSSD = (bf16_t*)(ws + WS_YSSD); bf16_t* MIXIN = (bf16_t*)(ws + WS_MIXIN); bf16_t* MIX = (bf16_t*)(ws + WS_MIX); bf16_t* FB = (bf16_t*)(ws + WS_FB); bf16_t* H1 = (bf16_t*)(ws + WS_H1);
    bf16_t* ACT = (bf16_t*)(ws + WS_ACT);
    bf16_t* XN = (bf16_t*)P.out + 4 * 1024;
    bf16_t* OSB = (bf16_t*)P.out;

    {
        LAS float* scr = (LAS float*)(lds + wave * 16384);
        constexpr int I_IN = 16 * 184, I_OUT = 32 * 32, I_UP = 16 * 176, I_DN = 44 * 32, NIT = I_IN + I_OUT + I_UP + I_DN;
        for (int it = gw; it < NIT; it += NGW) {
            int q = it;
            if (q < I_IN) { p0_transpose_item(P.w_in, 1024, INC, WIN, scr, q / 184, 32 * (q % 184), 32 * (q % 184), lane); continue; } q -= I_IN;
            if (q < I_OUT) { p0_transpose_item(P.w_out, 2048, 1024, WOUT, scr, q / 32, 32 * (q % 32), 32 * (q % 32), lane); continue; } q -= I_OUT;
            if (q < I_UP) { const int kb = q / 176, nb = q % 176, dn0 = 32 * nb, pn = dn0 >> 8, within = dn0 & 255;
                const int sn0 = (within < 128) ? (128 * pn + within) : (DFF + 128 * pn + within - 128);
                p0_transpose_item(P.w_up, 1024, NUP, WUP, scr, kb, sn0, dn0, lane); continue; } q -= I_UP;
            p0_transpose_item(P.w_down, DFF, 1024, WDN, scr, q / 32, 32 * (q % 32), 32 * (q % 32), lane);
        }
        for (int t0 = gw; t0 < TT; t0 += 2 * NGW) {
            f32x4 v[2][4]; int tt[2];
#pragma unroll
            for (int u = 0; u < 2; ++u) { const int t = t0 + u * NGW; tt[u] = t; const int tc = t < TT ? t : TT - 1;
                const int b = tc / LL, p = tc - b * LL;
                const float* src = (p < NMETA) ? P.meta + (size_t)p * 1024 : P.x + ((size_t)b * SEQ + p - NMETA) * 1024;
#pragma unroll
                for (int j = 0; j < 4; ++j) v[u][j] = __builtin_nontemporal_load((const f32x4*)src + lane + 64 * j); }
#pragma unroll
            for (int u = 0; u < 2; ++u) { const int t = tt[u];
                if (t < TT) rms_store_bf16(v[u], P.mix_pre_g, XN + (size_t)t * 1024, lane); }
        }
    }
    if (P.ws == nullptr) grid.sync();
    xcd_barrier(xbar);
    asm volatile("" : "+v"(lane));
    {
        pg8::Gemm g{XN, WIN, 131 * 256, NP1, 1024, 1024, 1024, 253, -3}; pg8::StaticOrder S; S.init(131 * 256, NP1, G, bid);
        pg8::EpiProjConv E{PROJ, P.conv_w, P.conv_b};
        pg8::gemm_phase<pg8::EpiProjConv, pg8::StaticOrder, true>(lds, g, S, E);
    }
    xcd_barrier(xbar);
    asm volatile("" : "+v"(lane));
    {
        constexpr int NA = NB * 16 * 129;
        const int nssdb = G > 128 ? 128 : G;
        constexpr int NA1 = NA;
        if (bid < nssdb) for (int it = bid; it < 128; it += nssdb) {
            const int xcd = it & 7, slot = it >> 3, pair = xcd * 2 + (slot >> 3), item = ((pair >> 1) << 4) + (pair & 1) * 8 + (slot & 7);
            ssd_item(P, lds, item, tid, wave, lane); }
        if (G > 128) {
            if (bid >= 128 && G == 256) {
                const int ab = bid - 128, xcd = ab & 7, ws = (ab >> 3) * NWAVES + wave;
                for (int j = ws; j < 16 * 129; j += 128) {
                    int qi, bi;
                    if (j < 16 * 127) { bi = j / 127; qi = 2 + (j - bi * 127); } else if (j < 16 * 128) { qi = 1; bi = j - 16 * 127; } else { qi = 0; bi = j - 16 * 128; }
                    attn_item(P, qi, xcd + 8 * bi, lane); }
            } else if (bid >= 128) { for (int it = (bid - 128) * NWAVES + wave; it < NA1; it += (G - 128) * NWAVES) attn_item(P, it % 129, it / 129, lane); }
            else { for (int it = NA1 + bid * NWAVES + wave; it < NA; it += 128 * NWAVES) attn_item(P, it % 129, it / 129, lane); }
        } else for (int it = gw; it < NA; it += NGW) attn_item(P, it % 129, it / 129, lane);
    }
    xcd_barrier(xbar);
    asm volatile("" : "+v"(lane));
    {
        for (int t0 = gw; t0 < TT; t0 += 4 * NGW) {
            u32x4 q[4][2][2]; int tt[4];
#pragma unroll
            for (int u = 0; u < 4; ++u) { const int t = t0 + u * NGW; tt[u] = t; const int tc = t < TT ? t : TT - 1;
#pragma unroll
                for (int half = 0; half < 2; ++half) { const bf16_t* src = (half ? OSB : YSSD) + (size_t)tc * 1024;
#pragma unroll
                    for (int j = 0; j < 2; ++j) q[u][half][j] = __builtin_nontemporal_load((const u32x4*)src + lane + 64 * j); } }
#pragma unroll
            for (int u = 0; u < 4; ++u) { const int t = tt[u]; if (t >= TT) continue;
                bf16_t* orow = MIXIN + (size_t)t * MIXW;
#pragma unroll
                for (int half = 0; half < 2; ++half) {
                    const float* gg = half ? P.sb_norm_g : P.ssd_norm_g;
                    float v[16]; float s = 0.f;
#pragma unroll
                    for (int j = 0; j < 2; ++j) { const u32x4 qq = q[u][half][j];
                        v[8 * j + 0] = bflo(qq.x); v[8 * j + 1] = bfhi(qq.x); v[8 * j + 2] = bflo(qq.y); v[8 * j + 3] = bfhi(qq.y); v[8 * j + 4] = bflo(qq.z); v[8 * j + 5] = bfhi(qq.z); v[8 * j + 6] = bflo(qq.w); v[8 * j + 7] = bfhi(qq.w); }
#pragma unroll
                    for (int j = 0; j < 16; ++j) s += v[j] * v[j];
                    const float rs = 1.f / sqrtf(wave_sum(s) * (1.f / 1024.f) + EPS);
#pragma unroll
                    for (int j = 0; j < 2; ++j) { const f32x4 ga = *(const f32x4*)(gg + 8 * lane + 512 * j), gb = *(const f32x4*)(gg + 8 * lane + 512 * j + 4); u32x4 w;
                        w.x = pk2(v[8 * j + 0] * rs * ga.x, v[8 * j + 1] * rs * ga.y); w.y = pk2(v[8 * j + 2] * rs * ga.z, v[8 * j + 3] * rs * ga.w);
                        w.z = pk2(v[8 * j + 4] * rs * gb.x, v[8 * j + 5] * rs * gb.y); w.w = pk2(v[8 * j + 6] * rs * gb.z, v[8 * j + 7] * rs * gb.w);
                        *((u32x4*)(orow + half * 1024) + lane + 64 * j) = w; }
                }
            }
        }
    }
    xcd_barrier(xbar);
    asm volatile("" : "+v"(lane));
    {
        thin_outproj(MIXIN + (size_t)(NB * SEQ) * MIXW, WOUT, MIX + (size_t)(NB * SEQ) * 1024, lds, bid, G, wave, lane);
        pg8::Gemm g{MIXIN, WOUT, NB * SEQ, 1024, MIXW, MIXW, MIXW, 256, 0}; pg8::StaticOrder S; S.init(NB * SEQ, 1024, G, bid);
        pg8::EpiBf16 E{MIX, 1024, 1024, MIX, 1024, 0, 0, 0};
        pg8::gemm_phase<pg8::EpiBf16, pg8::StaticOrder, true>(lds, g, S, E);
    }
    xcd_barrier(xbar);
    asm volatile("" : "+v"(lane));
    {
        for (int t0 = gw; t0 < TT; t0 += 2 * NGW) {
            f32x4 m[2][4], xv[2][4]; int tt[2];
#pragma unroll
            for (int u = 0; u < 2; ++u) { const int t = t0 + u * NGW; tt[u] = t; const int tc = t < TT ? t : TT - 1;
                const int b = tc / LL, p = tc - b * LL;
                const float* src = (p < NMETA) ? P.meta + (size_t)p * 1024 : P.x + ((size_t)b * SEQ + p - NMETA) * 1024;
#pragma unroll
                for (int j = 0; j < 4; ++j) { const u32x2 mq = __builtin_nontemporal_load((const u32x2*)(MIX + (size_t)tc * 1024) + lane + 64 * j);
                    m[u][j] = (f32x4){bflo(mq.x), bfhi(mq.x), bflo(mq.y), bfhi(mq.y)}; xv[u][j] = __builtin_nontemporal_load((const f32x4*)src + lane + 64 * j); } }
#pragma unroll
            for (int u = 0; u < 2; ++u) { const int t = tt[u]; if (t >= TT) continue;
                float s = 0.f; f32x4 hv[4];
#pragma unroll
                for (int j = 0; j < 4; ++j) s += (m[u][j].x * m[u][j].x + m[u][j].y * m[u][j].y) + (m[u][j].z * m[u][j].z + m[u][j].w * m[u][j].w);
                const float rs = 1.f / sqrtf(wave_sum(s) * (1.f / 1024.f) + EPS);
#pragma unroll
                for (int j = 0; j < 4; ++j) { const f32x4 gg = *((const f32x4*)P.mix_post_g + lane + 64 * j);
                    hv[j] = xv[u][j] + m[u][j] * rs * gg; u32x2 hq; hq.x = pk2(hv[j].x, hv[j].y); hq.y = pk2(hv[j].z, hv[j].w); __builtin_nontemporal_store(hq, (u32x2*)(H1 + (size_t)t * 1024) + lane + 64 * j); }
                rms_store_bf16(hv, P.ffn_pre_g, XN + (size_t)t * 1024, lane);
            }
        }
    }
    xcd_barrier(xbar);
    asm volatile("" : "+v"(lane));
    {
        pg8::Gemm g{XN, WUP, 130 * 256, NUP, 1024, 1024, 1024, 254, -2}; pg8::StaticOrder S; S.init(130 * 256, NUP, G, bid);
        pg8::EpiUpConv E{ACT, P.fconv_w, P.fconv_b};
        pg8::gemm_phase<pg8::EpiUpConv, pg8::StaticOrder, true>(lds, g, S, E);
    }
    xcd_barrier(xbar);
    asm volatile("" : "+v"(lane));
    {
        pg8::Gemm g{ACT, WDN, NB * SEQ, 1024, DFF, DFF, DFF, 256, 0}; pg8::StaticOrder S; S.init(NB * SEQ, 1024, G, bid);
        pg8::EpiBf16 E{FB, 1024, 1024, FB, 1024, 0, 0, 0};
        pg8::gemm_phase<pg8::EpiBf16, pg8::StaticOrder, true>(lds, g, S, E);
    }
    xcd_barrier(xbar);
    asm volatile("" : "+v"(lane));
    {
        for (int t0 = gw; t0 < NB * SEQ; t0 += 2 * NGW) {
            f32x4 f[2][4], hv[2][4];
#pragma unroll
            for (int u = 0; u < 2; ++u) { int tr = t0 + u * NGW; tr = tr < NB * SEQ ? tr : NB * SEQ - 1;
                const int b = tr / SEQ, s = tr - b * SEQ; const size_t t = (size_t)b * LL + NMETA + s;
#pragma unroll
                for (int j = 0; j < 4; ++j) { const u32x2 fq2 = __builtin_nontemporal_load((const u32x2*)(FB + (size_t)tr * 1024) + lane + 64 * j);
                    f[u][j] = (f32x4){bflo(fq2.x), bfhi(fq2.x), bflo(fq2.y), bfhi(fq2.y)}; const u32x2 hq = __builtin_nontemporal_load((const u32x2*)(H1 + t * 1024) + lane + 64 * j); hv[u][j] = (f32x4){bflo(hq.x), bfhi(hq.x), bflo(hq.y), bfhi(hq.y)}; } }
#pragma unroll
            for (int u = 0; u < 2; ++u) { const int tr = t0 + u * NGW; if (tr >= NB * SEQ) continue;
                float ss = 0.f;
#pragma unroll
                for (int j = 0; j < 4; ++j) ss += (f[u][j].x * f[u][j].x + f[u][j].y * f[u][j].y) + (f[u][j].z * f[u][j].z + f[u][j].w * f[u][j].w);
                const float rs = 1.f / sqrtf(wave_sum(ss) * (1.f / 1024.f) + EPS);
                f32x4* orow = (f32x4*)(P.out + (size_t)tr * 1024);
#pragma unroll
                for (int j = 0; j < 4; ++j) { const f32x4 gg = *((const f32x4*)P.ffn_post_g + lane + 64 * j); __builtin_nontemporal_store(hv[u][j] + f[u][j] * rs * gg, &orow[lane + 64 * j]); }
            }
        }
    }
}

extern "C" void kernel_launch(void* const* d_in, const int* in_sizes, int n_in, void* d_out, int out_size, void* d_ws, size_t ws_size, hipStream_t stream) {
    static int grid = 0;
    if (grid == 0) {
        if (n_in != 19 || ws_size < WS_NEED || out_size != NB * SEQ * DM) { fprintf(stderr, "kernel_launch: unexpected problem (n_in %d, ws %zu, out %d)\n", n_in, ws_size, out_size); grid = -1; return; }
        int dev = 0, cus = 0, per_cu = 0;
        hipGetDevice(&dev); hipDeviceGetAttribute(&cus, hipDeviceAttributeMultiprocessorCount, dev);
        if (hipFuncSetAttribute((const void*)hymba_fwd, hipFuncAttributeMaxDynamicSharedMemorySize, LDS_BYTES) != hipSuccess) { fprintf(stderr, "kernel_launch: hipFuncSetAttribute failed\n"); grid = -1; return; }
        if (hipOccupancyMaxActiveBlocksPerMultiprocessor(&per_cu, (const void*)hymba_fwd, NTHR, LDS_BYTES) != hipSuccess || per_cu < 1) { fprintf(stderr, "kernel_launch: occupancy query failed (%d)\n", per_cu); per_cu = 1; }
        (void)hipGetLastError();
        grid = cus * (per_cu > 1 ? 1 : per_cu);
    }
    if (grid < 0) return;
    Params p{};
    p.x = (const float*)d_in[0]; p.meta = (const float*)d_in[1]; p.mix_pre_g = (const float*)d_in[2]; p.w_in = (const float*)d_in[3]; p.conv_w = (const float*)d_in[4]; p.conv_b = (const float*)d_in[5];
    p.dt_bias = (const float*)d_in[6]; p.a_log = (const float*)d_in[7]; p.d_skip = (const float*)d_in[8]; p.ssd_norm_g = (const float*)d_in[9]; p.sb_norm_g = (const float*)d_in[10];
    p.w_out = (const float*)d_in[11]; p.mix_post_g = (const float*)d_in[12]; p.ffn_pre_g = (const float*)d_in[13]; p.w_up = (const float*)d_in[14]; p.fconv_w = (const float*)d_in[15];
    p.fconv_b = (const float*)d_in[16]; p.w_down = (const float*)d_in[17]; p.ffn_post_g = (const float*)d_in[18];
    p.out = (float*)d_out; p.ws = (unsigned char*)d_ws;
    if (hipMemsetAsync(d_ws, 0, XCD_BAR_WORDS * 4, stream) != hipSuccess) { fprintf(stderr, "kernel_launch: memset of the barrier words failed\n"); return; }
    void* args[] = {&p};
    hipError_t e = hipLaunchCooperativeKernel((const void*)hymba_fwd, dim3(grid), dim3(NTHR), args, LDS_BYTES, stream);
    if (e != hipSuccess) fprintf(stderr, "cooperative launch failed: %s (grid %d)\n", hipGetErrorString(e), grid);
}
```

```cpp
#include <hip/hip_runtime.h>
#include <hip/hip_cooperative_groups.h>
#include <cstdio>
#include <cstdint>
namespace cg = cooperative_groups;

#define LAS __attribute__((address_space(3)))
typedef unsigned short bf16_t;
typedef short bf16x8 __attribute__((ext_vector_type(8)));
typedef float f32x4 __attribute__((ext_vector_type(4)));
typedef float f32x16 __attribute__((ext_vector_type(16)));
typedef unsigned u32x4 __attribute__((ext_vector_type(4)));
typedef unsigned u32x2 __attribute__((ext_vector_type(2)));

constexpr int NB = 8, SEQ = 4096, NMETA = 16, LL = SEQ + NMETA  , TT = NB * LL  , MP = 33024  , DM = 1024;
constexpr int INC = 5648, NP1 = 5888  , LDP = 5648;
constexpr int OFF_Z = 0, OFF_XBC = 1024, OFF_DT = 2560, OFF_Q = 2576, OFF_K = 3600, OFF_V = 4624;
constexpr int XBCW = 1536, DFF = 2816, NUP = 5632, MIXW = 2048;
constexpr float EPS = 1e-6f;
constexpr int NWAVES = 8, NTHR = 512;
constexpr int LDS_BYTES = 163840;
constexpr int LDS_MISC = LDS_BYTES - 64;

constexpr size_t MiB = 1u << 20;
constexpr size_t WS_WUP = 1 * MiB, WS_WDN = 12 * MiB, WS_WIN = 18 * MiB, WS_WOUT = 30 * MiB;
constexpr size_t WS_PROJ = 34 * MiB;
constexpr size_t WS_YSSD = 390 * MiB;
constexpr size_t WS_MIXIN = 34 * MiB;
constexpr size_t WS_MIX = 170 * MiB;
constexpr size_t WS_FB = 200 * MiB;
constexpr size_t WS_H1 = 383 * MiB;
constexpr size_t WS_ACT = 18 * MiB;
constexpr size_t WS_NEED = 512 * MiB;

namespace pg8 {
constexpr int BM = 256, BK = 64, HALF = 128, HTB = HALF * BK * 2, STAGE_BYTES = 8 * HTB, NXCD = 8, WGM = 4;
__host__ __device__ __forceinline__ int lds_byte(int r, int c) { const int st = (r >> 4) * 2 + (c >> 5), rr = r & 15, cc = c & 31, ob = rr * 64 + cc * 2; return st * 1024 + (ob ^ (((ob >> 9) & 1) << 5)); }
__host__ __device__ __forceinline__ void stage_rc(int b, int& R, int& C) { const int st = b / 1024, sb = b % 1024, swz = sb ^ (((sb >> 9) & 1) << 5); R = (st >> 1) * 16 + swz / 64; C = (st & 1) * 32 + (swz % 64) / 2; }
__host__ __device__ __forceinline__ int perm32(int rho) { const int n = rho >> 4, i = rho & 15; return 8 * (i >> 2) + 4 * n + (i & 3); }

struct Unit { int pm, pn; };
struct Gemm { const bf16_t* A; const bf16_t* Bt; int M, N, K, lda, ldb, mstride, moff; };

struct StaticOrder {
    int nM, nN, nwg, G, c;
    __host__ __device__ void init(int M, int N, int G_, int c_) { nM = M / BM; nN = N / BM; nwg = nM * nN; G = G_; c = c_; }
    __host__ __device__ bool next(int i, Unit& u) const {
        const long L = (long)i * G + c; if (L >= nwg) return false;
        int wgid = (int)L; { const int q = nwg / NXCD, r = nwg % NXCD, xcd = wgid % NXCD, off = wgid / NXCD; wgid = (xcd < r ? xcd * (q + 1) : r * (q + 1) + (xcd - r) * q) + off; }
        const int nig = WGM * nN, gid = wgid / nig, fm = gid * WGM, gsz = (nM - fm) < WGM ? (nM - fm) : WGM;
        u.pm = fm + ((wgid % nig) % gsz); u.pn = (wgid % nig) / gsz; return true;
    }
};

__device__ __forceinline__ unsigned cvt_pk_bf16(float lo, float hi) { unsigned r; asm volatile("v_cvt_pk_bf16_f32 %0, %1, %2" : "=v"(r) : "v"(lo), "v"(hi)); return r; }

struct EpiBf16 {
    static constexpr bool PERM = true;
    bf16_t* O; int ldc; int ncols; bf16_t* O2; int ld2; int rt_lo, rt_hi, col2_0;
    __device__ __forceinline__ void operator()(const f32x4 (&acc)[2][2][4][2], const Unit& u, int wr, int wc, int fr, int fq, LAS unsigned char* hb) const {
        const int row0 = u.pm * BM + wr * 64 + fr; const int col0 = u.pn * BM + wc * 32 + 8 * fq;
        const bool redir = (u.pn >= rt_lo && u.pn < rt_hi);
        bf16_t* base = redir ? O2 : O; const int ld = redir ? ld2 : ldc; const int cofs = redir ? col2_0 : 0;
#pragma unroll
        for (int ai = 0; ai < 2; ++ai)
#pragma unroll
            for (int m = 0; m < 4; ++m) { bf16_t* rowp = base + (size_t)(row0 + ai * HALF + m * 16) * ld + (col0 - cofs);
#pragma unroll
                for (int bj = 0; bj < 2; ++bj) { const f32x4 v0 = acc[ai][bj][m][0], v1 = acc[ai][bj][m][1];
                    u32x4 w; w.x = cvt_pk_bf16(v0[0], v0[1]); w.y = cvt_pk_bf16(v0[2], v0[3]); w.z = cvt_pk_bf16(v1[0], v1[1]); w.w = cvt_pk_bf16(v1[2], v1[3]);
                    if (col0 + bj * HALF < ncols) *(u32x4*)(rowp + bj * HALF) = w; } }
    }
};
template <bool REMAP> struct EpiF32 {
    static constexpr bool PERM = false;
    float* O; int ldc;
    __device__ __forceinline__ void operator()(const f32x4 (&acc)[2][2][4][2], const Unit& u, int wr, int wc, int fr, int fq, LAS unsigned char* hb) const {
        const int col0 = u.pn * BM + wc * 32 + 4 * fq;
#pragma unroll
        for (int ai = 0; ai < 2; ++ai)
#pragma unroll
            for (int m = 0; m < 4; ++m) { int row = u.pm * BM + ai * HALF + wr * 64 + m * 16 + fr; bool ok = true;
                if (REMAP) { const int b = row / LL, p = row - b * LL; ok = (row < TT) && (p >= NMETA); row = b * SEQ + p - NMETA; }
                if (ok) { float* rowp = O + (size_t)row * ldc + col0;
#pragma unroll
                    for (int bj = 0; bj < 2; ++bj)
#pragma unroll
                        for (int n = 0; n < 2; ++n) *(f32x4*)(rowp + bj * HALF + n * 16) = acc[ai][bj][m][n]; } }
    }
};


template <int D> __device__ __forceinline__ float dpp_row_shr(float oldv, float v) {
    return __builtin_bit_cast(float, __builtin_amdgcn_update_dpp(__builtin_bit_cast(int, oldv), __builtin_bit_cast(int, v), 0x110 + D, 0xf, 0xf, false)); }
__device__ __forceinline__ unsigned pk2e(float lo, float hi) { typedef __bf16 b2 __attribute__((ext_vector_type(2))); b2 v; v.x = (__bf16)lo; v.y = (__bf16)hi; return __builtin_bit_cast(unsigned, v); }
__device__ __forceinline__ void unpack8(const u32x4 q, float (&o)[8]) {
    o[0] = __builtin_bit_cast(float, q.x << 16); o[1] = __builtin_bit_cast(float, q.x & 0xffff0000u); o[2] = __builtin_bit_cast(float, q.y << 16); o[3] = __builtin_bit_cast(float, q.y & 0xffff0000u);
    o[4] = __builtin_bit_cast(float, q.z << 16); o[5] = __builtin_bit_cast(float, q.z & 0xffff0000u); o[6] = __builtin_bit_cast(float, q.w << 16); o[7] = __builtin_bit_cast(float, q.w & 0xffff0000u); }
__device__ __forceinline__ float ex2(float x) { return __builtin_amdgcn_exp2f(x); }

struct EpiProjConv {
    static constexpr bool PERM = true;
    bf16_t* O; const float* cw; const float* cb;
    __device__ __forceinline__ void operator()(const f32x4 (&acc)[2][2][4][2], const Unit& u, int wr, int wc, int fr, int fq, LAS unsigned char* hb) const {
        constexpr int H = 3, NCH = 256;
        int chl = wc * 32 + 8 * fq; asm volatile("" : "+v"(chl), "+v"(fr));
        const int R0 = 253 * u.pm - 3;
        const bool convt = (u.pn >= 4 && u.pn < 10);
        if (!convt) {
            const int col0 = u.pn * BM + chl;
#pragma unroll
            for (int ai = 0; ai < 2; ++ai)
#pragma unroll
                for (int m = 0; m < 4; ++m) { const int lr = ai * HALF + wr * 64 + m * 16 + fr, R = R0 + lr;
                    if (lr >= H && R < TT) { char* rowp = (char*)O + ((unsigned)R * (unsigned)LDP + (unsigned)col0) * 2u;
#pragma unroll
                        for (int bj = 0; bj < 2; ++bj) { const f32x4 v0 = acc[ai][bj][m][0], v1 = acc[ai][bj][m][1];
                            u32x4 w; w.x = pk2e(v0[0], v0[1]); w.y = pk2e(v0[2], v0[3]); w.z = pk2e(v1[0], v1[1]); w.w = pk2e(v1[2], v1[3]);
                            if (col0 + bj * HALF < INC) *(u32x4*)(rowp + bj * HALF * 2) = w; } } }
            return;
        }
        if (fr >= 16 - H) {
#pragma unroll
            for (int ai = 0; ai < 2; ++ai)
#pragma unroll
                for (int m = 0; m < 4; ++m) { const int q = 8 * ai + 4 * wr + m; asm volatile("" ::: "memory");
#pragma unroll
                    for (int bj = 0; bj < 2; ++bj) { const f32x4 v0 = acc[ai][bj][m][0], v1 = acc[ai][bj][m][1];
                        u32x4 w; w.x = pk2e(v0[0], v0[1]); w.y = pk2e(v0[2], v0[3]); w.z = pk2e(v1[0], v1[1]); w.w = pk2e(v1[2], v1[3]);
                        *(LAS u32x4*)(hb + ((q * H + fr - (16 - H)) * NCH + bj * HALF + chl) * 2) = w; } }
        }
        asm volatile("s_waitcnt lgkmcnt(0)" ::: "memory"); __builtin_amdgcn_s_barrier(); asm volatile("" ::: "memory");
        const int hr1 = H - 1, hr2 = (H - 2 + fr) < (H - 1) ? (H - 2 + fr) : (H - 1), hr3 = (H - 3 + fr) < (H - 1) ? (H - 3 + fr) : (H - 1);
        const int ch0 = (u.pn - 4) * BM + chl;
#pragma unroll
        for (int ai = 0; ai < 2; ++ai)
#pragma unroll
            for (int m = 0; m < 4; ++m) { asm volatile("" ::: "memory"); __builtin_amdgcn_sched_barrier(0);
                const int q = 8 * ai + 4 * wr + m, prev = q > 0 ? q - 1 : 0; const int lr = ai * HALF + wr * 64 + m * 16 + fr, R = R0 + lr;
                const int Rc = R < 0 ? 0 : R; const int b = Rc / LL, p = Rc - b * LL;
                const bool ok = (lr >= H && R < TT);
                const unsigned ooff = ((unsigned)Rc * (unsigned)LDP + (unsigned)(OFF_XBC + ch0)) * 2u;
#pragma unroll
                for (int bn = 0; bn < 4; ++bn) { const int bj = bn >> 1, n = bn & 1; const int co = bj * HALF + 4 * n;
                    const unsigned woff = (unsigned)(ch0 + co) * 4u;
                    const f32x4 w0 = *(const f32x4*)((const char*)cw + woff), w1 = *(const f32x4*)((const char*)cw + woff + XBCW * 4), w2 = *(const f32x4*)((const char*)cw + woff + 2 * XBCW * 4), w3 = *(const f32x4*)((const char*)cw + woff + 3 * XBCW * 4), bs = *(const f32x4*)((const char*)cb + woff);
                    const LAS unsigned char* hp = hb + (prev * H * NCH + chl + co) * 2;
                    const u32x2 q1 = *(const LAS u32x2*)(hp + hr1 * NCH * 2), q2 = *(const LAS u32x2*)(hp + hr2 * NCH * 2), q3 = *(const LAS u32x2*)(hp + hr3 * NCH * 2);
                    const float h1[4] = {__builtin_bit_cast(float, q1.x << 16), __builtin_bit_cast(float, q1.x & 0xffff0000u), __builtin_bit_cast(float, q1.y << 16), __builtin_bit_cast(float, q1.y & 0xffff0000u)};
                    const float h2[4] = {__builtin_bit_cast(float, q2.x << 16), __builtin_bit_cast(float, q2.x & 0xffff0000u), __builtin_bit_cast(float, q2.y << 16), __builtin_bit_cast(float, q2.y & 0xffff0000u)};
                    const float h3[4] = {__builtin_bit_cast(float, q3.x << 16), __builtin_bit_cast(float, q3.x & 0xffff0000u), __builtin_bit_cast(float, q3.y << 16), __builtin_bit_cast(float, q3.y & 0xffff0000u)};
                    const f32x4 gv = acc[ai][bj][m][n];
                    float o[4];
#pragma unroll
                    for (int j = 0; j < 4; ++j) { const float g = gv[j];
                        float g1 = dpp_row_shr<1>(h1[j], g), g2 = dpp_row_shr<2>(h2[j], g), g3 = dpp_row_shr<3>(h3[j], g);
                        g1 = p >= 1 ? g1 : 0.f; g2 = p >= 2 ? g2 : 0.f; g3 = p >= 3 ? g3 : 0.f;
                        const float v = bs[j] + w3[j] * g + w2[j] * g1 + w1[j] * g2 + w0[j] * g3;
                        o[j] = v * __builtin_amdgcn_rcpf(1.f + ex2(-1.4426950408889634f * v)); }
                    if (ok) { u32x2 w; w.x = pk2e(o[0], o[1]); w.y = pk2e(o[2], o[3]); *(u32x2*)((char*)O + ooff + co * 2) = w; }
                    asm volatile("" ::: "memory"); }
            }
    }
};
struct EpiUpConv {
    static constexpr bool PERM = true;
    bf16_t* ACT; const float* cw; const float* cb;
    __device__ __forceinline__ void operator()(const f32x4 (&acc)[2][2][4][2], const Unit& u, int wr, int wc, int fr, int fq, LAS unsigned char* hb) const {
        constexpr int H = 2, NCH = 128;
        int chl = wc * 32 + 8 * fq; asm volatile("" : "+v"(chl), "+v"(fr));
        const int R0 = 254 * u.pm - 2; const int ch = u.pn * HALF + chl;
        if (fr >= 16 - H) {
#pragma unroll
            for (int ai = 0; ai < 2; ++ai)
#pragma unroll
                for (int m = 0; m < 4; ++m) { const int q = 8 * ai + 4 * wr + m;
                    LAS f32x4* hw = (LAS f32x4*)(hb + ((q * H + fr - (16 - H)) * NCH + chl) * 4); hw[0] = acc[ai][0][m][0]; hw[1] = acc[ai][0][m][1]; }
        }
        asm volatile("s_waitcnt lgkmcnt(0)" ::: "memory"); __builtin_amdgcn_s_barrier(); asm volatile("" ::: "memory");
        const int hr1 = H - 1, hr2 = (H - 2 + fr) < (H - 1) ? (H - 2 + fr) : (H - 1);
#pragma unroll
        for (int n = 0; n < 2; ++n) { asm volatile("" ::: "memory");
            const int c4 = ch + 4 * n;
            const f32x4 w0 = *(const f32x4*)(cw + 0 * DFF + c4), w1 = *(const f32x4*)(cw + 1 * DFF + c4), w2 = *(const f32x4*)(cw + 2 * DFF + c4), bs = *(const f32x4*)(cb + c4);
#pragma unroll
            for (int ai = 0; ai < 2; ++ai)
#pragma unroll
                for (int m = 0; m < 4; ++m) { const int q = 8 * ai + 4 * wr + m, prev = q > 0 ? q - 1 : 0; const int lr = ai * HALF + wr * 64 + m * 16 + fr, R = R0 + lr;
                    const int Rc = R < 0 ? 0 : R; const int b = Rc / LL, p = Rc - b * LL;
                    const LAS unsigned char* hp = hb + (prev * H * NCH + chl + 4 * n) * 4;
                    const f32x4 h1 = *(const LAS f32x4*)(hp + hr1 * NCH * 4), h2 = *(const LAS f32x4*)(hp + hr2 * NCH * 4);
                    const f32x4 gv = acc[ai][0][m][n], uv = acc[ai][1][m][n];
                    float o[4];
#pragma unroll
                    for (int j = 0; j < 4; ++j) { const float g = gv[j];
                        float g1 = dpp_row_shr<1>(h1[j], g), g2 = dpp_row_shr<2>(h2[j], g);
                        g1 = p >= 1 ? g1 : 0.f; g2 = p >= 2 ? g2 : 0.f;
                        const float v = bs[j] + w2[j] * g + w1[j] * g1 + w0[j] * g2;
                        const float a = v + 0.044715f * v * v * v;
                        const float ge = v * __builtin_amdgcn_rcpf(1.f + ex2(-2.f * 0.7978845608028654f * 1.4426950408889634f * a));
                        o[j] = ge * uv[j]; }
                    if (lr >= H && R < TT && p >= NMETA) { u32x2 w; w.x = pk2e(o[0], o[1]); w.y = pk2e(o[2], o[3]);
                        *(u32x2*)(ACT + ((size_t)b * SEQ + p - NMETA) * DFF + c4) = w; } }
        }
    }
};

template <class Epi, class Sched, bool ALIGN_EPI = true>
__device__ __forceinline__ void gemm_phase(LAS unsigned char* lds, const Gemm g, const Sched& S, const Epi& E) {
    int tid_ = threadIdx.x; asm volatile("" : "+v"(tid_));
    const int tid = tid_, wid = __builtin_amdgcn_readfirstlane(tid >> 6), lane = tid & 63, wr = wid >> 2, wc = wid & 3, fr = lane & 15, fq = lane >> 4;
    const int K = g.K, nt = K / BK;
    unsigned voffA[2], voffB[2];
#pragma unroll
    for (int i = 0; i < 2; ++i) { int R, C; stage_rc(tid * 16 + i * 8192, R, C); const int Rb = Epi::PERM ? ((R & ~31) + perm32(R & 31)) : R;
        voffA[i] = (unsigned)(R * g.lda + C) * 2u; voffB[i] = (unsigned)(Rb * g.ldb + C) * 2u; }
    const size_t kstep = (size_t)(BK * 2);
    const size_t hsA = (size_t)HALF * g.lda * 2, hsB = (size_t)HALF * g.ldb * 2;
    const size_t tsB = 2 * hsB;
    const unsigned ldsw = (unsigned)wid * 1024u;
    const int aoff = lds_byte(wr * 64 + fr, fq * 8), boff = lds_byte(wc * 32 + fr, fq * 8);
#define PG8_SA(b, h) (((b) * 2 + (h)) * HTB)
#define PG8_SB(b, h) ((4 + (b) * 2 + (h)) * HTB)
#define PG8_STAGE(bufoff, gbase, voff) do { _Pragma("unroll") for (int _i = 0; _i < 2; ++_i) \
        __builtin_amdgcn_global_load_lds((const unsigned*)((const char*)(gbase) + (voff)[_i]), (LAS unsigned*)(lds + (bufoff) + ldsw + _i * 8192), 16, 0, 0); } while (0)
#define PG8_LDA(dst, b, h) do { _Pragma("unroll") for (int m = 0; m < 4; ++m) _Pragma("unroll") for (int k = 0; k < 2; ++k) dst[m][k] = *(const LAS bf16x8*)(lds + PG8_SA(b, h) + aoff + m * 2048 + k * 1024); } while (0)
#define PG8_LDB(dst, b, h) do { _Pragma("unroll") for (int n = 0; n < 2; ++n) _Pragma("unroll") for (int k = 0; k < 2; ++k) dst[n][k] = *(const LAS bf16x8*)(lds + PG8_SB(b, h) + boff + n * 2048 + k * 1024); } while (0)
#define PG8_MMA(ai, bj, At, Bt) do { __builtin_amdgcn_s_setprio(1); _Pragma("unroll") for (int m = 0; m < 4; ++m) _Pragma("unroll") for (int n = 0; n < 2; ++n) _Pragma("unroll") for (int k = 0; k < 2; ++k) \
        acc[ai][bj][m][n] = __builtin_amdgcn_mfma_f32_16x16x32_bf16(Bt[n][k], At[m][k], acc[ai][bj][m][n], 0, 0, 0); __builtin_amdgcn_s_setprio(0); } while (0)
#define PG8_WAIT_V(n) asm volatile("s_waitcnt vmcnt(" #n ")" ::: "memory")
#define PG8_WAIT_L(n) asm volatile("s_waitcnt lgkmcnt(" #n ")" ::: "memory")
#define PG8_BAR __builtin_amdgcn_s_barrier()
#define PG8_SCHED __builtin_amdgcn_sched_barrier(0)
    Unit cur, nxt; int ui = 0;
    if (!S.next(0, cur)) return;
    f32x4 acc[2][2][4][2];
#pragma unroll
    for (int a = 0; a < 2; ++a)
#pragma unroll
        for (int b = 0; b < 2; ++b)
#pragma unroll
            for (int m = 0; m < 4; ++m)
#pragma unroll
                for (int n = 0; n < 2; ++n) acc[a][b][m][n] = (f32x4){0.f, 0.f, 0.f, 0.f};
    bf16x8 At[4][2], B0[2][2], B1[2][2];
    const char* cA = (const char*)g.A + ((long)cur.pm * g.mstride + g.moff) * (long)(g.lda * 2); const char* cB = (const char*)g.Bt + (size_t)cur.pn * tsB;
    PG8_STAGE(PG8_SB(0, 0), cB, voffB); PG8_STAGE(PG8_SB(0, 1), cB + hsB, voffB); PG8_STAGE(PG8_SA(0, 0), cA, voffA); PG8_STAGE(PG8_SA(0, 1), cA + hsA, voffA);
    if (wr == 1) PG8_BAR;
    PG8_WAIT_V(2); PG8_BAR;
    PG8_STAGE(PG8_SB(1, 0), cB + kstep, voffB); PG8_STAGE(PG8_SA(1, 0), cA + kstep, voffA); PG8_STAGE(PG8_SB(1, 1), cB + hsB + kstep, voffB);
    PG8_WAIT_V(6); PG8_BAR;
    for (;;) {
        const bool has_next = S.next(ui + 1, nxt);
        const char* nA = has_next ? (const char*)g.A + ((long)nxt.pm * g.mstride + g.moff) * (long)(g.lda * 2) : cA; const char* nB = has_next ? (const char*)g.Bt + (size_t)nxt.pn * tsB : cB;
        for (int t = 0; t < nt; t += 2) {
            const bool last = (t == nt - 2);
            const char* a1 = cA + (size_t)(t + 1) * kstep;
            const char* a2 = last ? nA : cA + (size_t)(t + 2) * kstep; const char* b2 = last ? nB : cB + (size_t)(t + 2) * kstep;
            const char* a3 = a2 + kstep; const char* b3 = b2 + kstep;
            PG8_LDB(B0, 0, 0); PG8_LDB(B1, 0, 1); PG8_SCHED; PG8_LDA(At, 0, 0); PG8_STAGE(PG8_SA(1, 1), a1 + hsA, voffA);
            PG8_WAIT_V(8); PG8_WAIT_L(0); PG8_BAR; PG8_MMA(0, 0, At, B0); PG8_MMA(0, 1, At, B1); PG8_BAR; PG8_SCHED;
            PG8_LDA(At, 0, 1); PG8_STAGE(PG8_SB(0, 0), b2, voffB); PG8_STAGE(PG8_SB(0, 1), b2 + hsB, voffB); PG8_STAGE(PG8_SA(0, 0), a2, voffA);
            PG8_WAIT_V(8); PG8_WAIT_L(0); PG8_BAR; PG8_MMA(1, 0, At, B0); PG8_MMA(1, 1, At, B1); PG8_BAR; PG8_SCHED;
            PG8_LDB(B0, 1, 0); PG8_LDB(B1, 1, 1); PG8_SCHED; PG8_LDA(At, 1, 0); PG8_STAGE(PG8_SA(0, 1), a2 + hsA, voffA);
            PG8_WAIT_V(8); PG8_WAIT_L(0); PG8_BAR; PG8_MMA(0, 0, At, B0); PG8_MMA(0, 1, At, B1); PG8_BAR; PG8_SCHED;
            PG8_LDA(At, 1, 1); PG8_STAGE(PG8_SB(1, 0), b3, voffB); PG8_STAGE(PG8_SB(1, 1), b3 + hsB, voffB); PG8_STAGE(PG8_SA(1, 0), a3, voffA);
            PG8_WAIT_V(8); PG8_WAIT_L(0); PG8_BAR; PG8_MMA(1, 0, At, B0); PG8_MMA(1, 1, At, B1); PG8_BAR; PG8_SCHED;
        }
        if constexpr (ALIGN_EPI) { if (wr == 0) PG8_BAR; }
        E(acc, cur, wr, wc, fr, fq, lds + STAGE_BYTES);
        if (!has_next) break;
#pragma unroll
        for (int a = 0; a < 2; ++a)
#pragma unroll
            for (int b = 0; b < 2; ++b)
#pragma unroll
                for (int m = 0; m < 4; ++m)
#pragma unroll
                    for (int n = 0; n < 2; ++n) acc[a][b][m][n] = (f32x4){0.f, 0.f, 0.f, 0.f};
        cur = nxt; cA = nA; cB = nB; ++ui;
        if constexpr (ALIGN_EPI) { if (wr == 1) PG8_BAR; }
    }
    PG8_WAIT_V(0);
    if constexpr (!ALIGN_EPI) { if (wr == 0) PG8_BAR; }
    PG8_BAR;
#undef PG8_SA
#undef PG8_SB
#undef PG8_STAGE
#undef PG8_LDA
#undef PG8_LDB
#undef PG8_MMA
#undef PG8_WAIT_V
#undef PG8_WAIT_L
#undef PG8_BAR
#undef PG8_SCHED
}
}

#define LDS_WAIT() asm volatile("s_waitcnt lgkmcnt(0)" ::: "memory")
typedef __bf16 bf16v2 __attribute__((ext_vector_type(2)));
__device__ __forceinline__ unsigned pk2(float lo, float hi) { bf16v2 v; v.x = (__bf16)lo; v.y = (__bf16)hi; return __builtin_bit_cast(unsigned, v); }
__device__ __forceinline__ unsigned f2bf(float f) { return pk2(f, 0.f) & 0xffffu; }
__device__ __forceinline__ float bf2f(unsigned short h) { return __builtin_bit_cast(float, (unsigned)h << 16); }
__device__ __forceinline__ float bflo(unsigned w) { return __builtin_bit_cast(float, w << 16); }
__device__ __forceinline__ float bfhi(unsigned w) { return __builtin_bit_cast(float, w & 0xffff0000u); }
__device__ __forceinline__ float wave_sum(float v) {
#pragma unroll
    for (int o = 1; o < 64; o <<= 1) v += __shfl_xor(v, o);
    return v;
}
template <int CTRL, int ROWMASK> __device__ __forceinline__ float dppf(float v) {
    return __builtin_bit_cast(float, __builtin_amdgcn_update_dpp(0, __builtin_bit_cast(int, v), CTRL, ROWMASK, 0xf, true)); }
__device__ __forceinline__ int crow(int r, int hi) { return (r & 3) + 8 * (r >> 2) + 4 * hi; }
__device__ __forceinline__ float fexp(float x) { return __builtin_amdgcn_exp2f(x * 1.4426950408889634f); }
__device__ __forceinline__ float silu(float v) { return v * __builtin_amdgcn_rcpf(1.f + fexp(-v)); }

struct Params {
    const float* x; const float* meta; const float* mix_pre_g; const float* w_in; const float* conv_w; const float* conv_b; const float* dt_bias;
    const float* a_log; const float* d_skip; const float* ssd_norm_g; const float* sb_norm_g; const float* w_out; const float* mix_post_g; const float* ffn_pre_g;
    const float* w_up; const float* fconv_w; const float* fconv_b; const float* w_down; const float* ffn_post_g;
    float* out; unsigned char* ws;
};

__device__ __forceinline__ void p0_transpose_item(const float* W, int K, int N, bf16_t* WT, LAS float* scr, int kb, int sn0, int dn0, int lane) {
    const int k0 = 64 * kb;
    const int n4 = 4 * (lane & 7), nn = sn0 + n4;
    f32x4 wv[8];
#pragma unroll
    for (int i = 0; i < 8; ++i) { const int kk = 8 * i + (lane >> 3); wv[i] = (nn < N) ? __builtin_nontemporal_load((const f32x4*)(W + (size_t)(k0 + kk) * N + nn)) : (f32x4){0.f, 0.f, 0.f, 0.f}; }
#pragma unroll
    for (int i = 0; i < 8; ++i) { const int kk = 8 * i + (lane >> 3); LAS float* d = scr + kk * 33 + n4; d[0] = wv[i].x; d[1] = wv[i].y; d[2] = wv[i].z; d[3] = wv[i].w; }
    LDS_WAIT(); asm volatile("" ::: "memory");
    const int c = lane & 7;
#pragma unroll
    for (int j = 0; j < 4; ++j) { const int n = (lane >> 3) + 8 * j; const LAS float* s = scr + (8 * c) * 33 + n;
        u32x4 o; o.x = pk2(s[0 * 33], s[1 * 33]); o.y = pk2(s[2 * 33], s[3 * 33]); o.z = pk2(s[4 * 33], s[5 * 33]); o.w = pk2(s[6 * 33], s[7 * 33]);
        *(u32x4*)(WT + (size_t)(dn0 + n) * K + k0 + 8 * c) = o; }
    LDS_WAIT(); asm volatile("" ::: "memory");
}

__device__ __forceinline__ void rms_store_bf16(const f32x4 (&v)[4], const float* g, bf16_t* orow, int lane) {
    float s = 0.f;
#pragma unroll
    for (int j = 0; j < 4; ++j) s += (v[j].x * v[j].x + v[j].y * v[j].y) + (v[j].z * v[j].z + v[j].w * v[j].w);
    const float rs = 1.f / sqrtf(wave_sum(s) * (1.f / 1024.f) + EPS);
    unsigned long long* o8 = (unsigned long long*)orow + lane;
#pragma unroll
    for (int j = 0; j < 4; ++j) { const f32x4 gg = *((const f32x4*)g + lane + 64 * j);
        o8[64 * j] = (unsigned long long)pk2(v[j].x * rs * gg.x, v[j].y * rs * gg.y) | ((unsigned long long)pk2(v[j].z * rs * gg.z, v[j].w * rs * gg.w) << 32); }
}
__device__ __forceinline__ void zero_row_bf16(bf16_t* orow, int ncol, int lane) {
    unsigned long long* o8 = (unsigned long long*)orow;
    for (int i = lane; i < ncol / 4; i += 64) o8[i] = 0ull;
}

constexpr int LP = 272;
template <int KS>
__device__ __forceinline__ f32x16 mma_nt(const LAS unsigned char* A, const LAS unsigned char* B, f32x16 acc, int lane) {
    const LAS unsigned char* ap = A + (lane & 31) * LP + (lane >> 5) * 16;
    const LAS unsigned char* bp = B + (lane & 31) * LP + (lane >> 5) * 16;
    bf16x8 a[KS], b[KS];
#pragma unroll
    for (int ks = 0; ks < KS; ++ks) { a[ks] = *(const LAS bf16x8*)(ap + ks * 32); b[ks] = *(const LAS bf16x8*)(bp + ks * 32); }
    __builtin_amdgcn_sched_barrier(0);
#pragma unroll
    for (int ks = 0; ks < KS; ++ks) acc = __builtin_amdgcn_mfma_f32_32x32x16_bf16(a[ks], b[ks], acc, 0, 0, 0);
    return acc;
}

constexpr int S_CC = 0, S_BC = 34816, S_MM = 69632, S_XDTT = 104448, S_XDDT = 121856, S_SB = 139264, S_ACS = 156672, S_DTV = 157696;
__device__ __forceinline__ void ssd_item(const Params& P, LAS unsigned char* lds, int item, int tid, int wave, int lane) {
    const int b = item >> 4, h = item & 15, g = h >> 3;
    const bf16_t* PROJ = (const bf16_t*)(P.ws + WS_PROJ); bf16_t* YS = (bf16_t*)(P.ws + WS_YSSD);
    const float dtb = P.dt_bias[h];
    const float Ah = -__expf(P.a_log[h]), Dh = P.d_skip[h];
    const int r = lane & 31, hh = lane >> 5;
    const int xrow0 = tid >> 3, xoct = tid & 7;
    const int brow0 = tid >> 5, bsel = (tid >> 4) & 1, boct = tid & 15;
    const int yb = wave & 3, pb = wave >> 2;
    const int ycol = h * 64 + pb * 32 + r;
    const __amdgpu_buffer_rsrc_t prs = __builtin_amdgcn_make_buffer_rsrc((void*)PROJ, 0, 0x7fffffff, 0x00020000);
    const __amdgpu_buffer_rsrc_t yrs = __builtin_amdgcn_make_buffer_rsrc((void*)YS, 0, 0x7fffffff, 0x00020000);
    const int yc = lane & 15, yg = lane >> 4;
    const unsigned zvoff = (unsigned)(4 * yg * LDP + OFF_Z + h * 64 + 4 * yc) * 2u, xvoff = (unsigned)(4 * yg * LDP + OFF_XBC + h * 64 + 4 * yc) * 2u, yvoff = (unsigned)(4 * yg * 1024 + h * 64 + 4 * yc) * 2u;
    f32x16 sacc; for (int i = 0; i < 16; ++i) sacc[i] = 0.f;
    for (int i = tid; i < 64 * LP / 4; i += NTHR) ((LAS unsigned*)(lds + S_SB))[i] = 0u;
    const size_t rowbase = (size_t)b * LL;
    u32x4 pbc[8], pxv[2]; unsigned pd0 = 0u, pd1 = 0u;
#define SSD_LOAD(cc) do { const int _p0 = 128 * (cc); const int _nv = (LL - _p0) < 128 ? (LL - _p0) : 128; \
        _Pragma("unroll") for (int k = 0; k < 8; ++k) { int _br = brow0 + 16 * k; _br = _br < _nv ? _br : _nv - 1;        \
            pbc[k] = *(const u32x4*)(PROJ + (rowbase + _p0 + _br) * LDP + OFF_XBC + 1024 + bsel * 256 + g * 128 + boct * 8); } \
        _Pragma("unroll") for (int q = 0; q < 2; ++q) { int _xr = xrow0 + 64 * q; _xr = _xr < _nv ? _xr : _nv - 1;        \
            pxv[q] = __builtin_nontemporal_load((const u32x4*)(PROJ + (rowbase + _p0 + _xr) * LDP + OFF_XBC + h * 64 + xoct * 8)); } \
        if (wave == 7) { const int _r0 = (2 * lane) < _nv ? 2 * lane : _nv - 1, _r1 = (2 * lane + 1) < _nv ? 2 * lane + 1 : _nv - 1; \
            pd0 = (unsigned)PROJ[(rowbase + _p0 + _r0) * LDP + OFF_DT + h]; pd1 = (unsigned)PROJ[(rowbase + _p0 + _r1) * LDP + OFF_DT + h]; } } while (0)
#define SSD_SCAN(cc) do { const int _nv = (LL - 128 * (cc)) < 128 ? (LL - 128 * (cc)) : 128; \
        LAS float* _acs = (LAS float*)(lds + S_ACS) + ((cc) & 1) * 128; LAS float* _dtv = (LAS float*)(lds + S_DTV) + ((cc) & 1) * 128; \
        const int r0 = 2 * lane, r1 = r0 + 1; const float v0 = bf2f((unsigned short)pd0) + dtb, v1 = bf2f((unsigned short)pd1) + dtb; \
        const float sp0 = fmaxf(v0, 0.f) + 0.6931471805599453f * __builtin_amdgcn_logf(1.f + __builtin_amdgcn_exp2f(-1.4426950408889634f * fabsf(v0))); \
        const float sp1 = fmaxf(v1, 0.f) + 0.6931471805599453f * __builtin_amdgcn_logf(1.f + __builtin_amdgcn_exp2f(-1.4426950408889634f * fabsf(v1))); \
        const float d0 = (r0 < _nv) ? sp0 : 0.f, d1 = (r1 < _nv) ? sp1 : 0.f; \
        const float a0 = d0 * Ah, a1 = d1 * Ah; float s = a0 + a1, inc = s; \
        inc += dppf<0x111, 0xf>(inc); inc += dppf<0x112, 0xf>(inc); inc += dppf<0x114, 0xf>(inc); inc += dppf<0x118, 0xf>(inc);     \
        inc += dppf<0x142, 0xa>(inc); inc += dppf<0x143, 0xc>(inc);                                                                  \
        const float ex = inc - s; \
        _acs[r0] = ex + a0; _acs[r1] = ex + a0 + a1; _dtv[r0] = d0; _dtv[r1] = d1; } while (0)
    SSD_LOAD(0);
    if (wave == 7) SSD_SCAN(0);
    asm volatile("" :: "v"(pbc[0]), "v"(pbc[1]), "v"(pbc[2]), "v"(pbc[3]), "v"(pbc[4]), "v"(pbc[5]), "v"(pbc[6]), "v"(pbc[7]), "v"(pxv[0]), "v"(pxv[1]));
    __syncthreads();
    for (int c = 0; c < 33; ++c) {
        const int p0 = 128 * c, nvalid = (LL - p0) < 128 ? (LL - p0) : 128;
        LAS float* ACS = (LAS float*)(lds + S_ACS) + (c & 1) * 128; LAS float* DTV = (LAS float*)(lds + S_DTV) + (c & 1) * 128;
#pragma unroll
        for (int k = 0; k < 8; ++k) { const int br = brow0 + 16 * k;
            u32x4 v = pbc[k]; if (br >= nvalid) v = (u32x4){0u, 0u, 0u, 0u};
            *(LAS u32x4*)(lds + (bsel ? S_CC : S_BC) + br * LP + boct * 16) = v; }
        {
            const float aend = ACS[127];
#pragma unroll
            for (int q = 0; q < 2; ++q) { const int s = xrow0 + 64 * q; const bool sv = s < nvalid;
                const float dtv = DTV[s], dd = fexp(aend - ACS[s]);
                const unsigned w4[4] = {pxv[q].x, pxv[q].y, pxv[q].z, pxv[q].w};
                const int sofs = (((s >> 3) ^ xoct) << 4) + (s & 7) * 2;
#pragma unroll
                for (int j = 0; j < 8; ++j) { float x = (j & 1) ? bfhi(w4[j >> 1]) : bflo(w4[j >> 1]); x = sv ? x : 0.f; const int p = xoct * 8 + j;
                    const float xd = x * dtv;
                    *(LAS unsigned short*)(lds + S_XDTT + p * LP + sofs) = (unsigned short)f2bf(xd);
                    *(LAS unsigned short*)(lds + S_XDDT + p * LP + sofs) = (unsigned short)f2bf(xd * dd); } }
        }
        __syncthreads();
        u32x2 zc[4], xc[4];
        {
            const int zb = __builtin_amdgcn_readfirstlane((int)(((unsigned)rowbase + p0 + wave * 16) * LDP * 2u));
#pragma unroll
            for (int i = 0; i < 4; ++i) { zc[i] = __builtin_bit_cast(u32x2, __builtin_amdgcn_raw_buffer_load_b64(prs, zvoff, zb + i * (LDP * 2), 2));
                                          xc[i] = __builtin_bit_cast(u32x2, __builtin_amdgcn_raw_buffer_load_b64(prs, xvoff, zb + i * (LDP * 2), 2)); }
        }
        if (c + 1 < 33) SSD_LOAD(c + 1);
        const int lb = wave >> 1, sb0 = 2 * (wave & 1);
        f32x16 g0, g1; for (int i = 0; i < 16; ++i) { g0[i] = 0.f; g1[i] = 0.f; }
        if (sb0 <= lb) g0 = mma_nt<4>(lds + S_CC + lb * 32 * LP + 128, lds + S_BC + sb0 * 32 * LP + 128, mma_nt<4>(lds + S_CC + lb * 32 * LP, lds + S_BC + sb0 * 32 * LP, g0, lane), lane);
        if (sb0 + 1 <= lb) g1 = mma_nt<4>(lds + S_CC + lb * 32 * LP + 128, lds + S_BC + (sb0 + 1) * 32 * LP + 128, mma_nt<4>(lds + S_CC + lb * 32 * LP, lds + S_BC + (sb0 + 1) * 32 * LP, g1, lane), lane);
        float al[16];
#pragma unroll
        for (int i = 0; i < 16; ++i) al[i] = ACS[lb * 32 + crow(i, hh)];
        {
            const float ref = ACS[lb > 0 ? lb * 32 - 1 : 0];
            float ul[16];
#pragma unroll
            for (int i = 0; i < 16; ++i) ul[i] = fexp(fminf(al[i] - ref, 0.f));
            if (sb0 <= lb) { const int s = sb0 * 32 + r; const float as = ACS[s];
                if (sb0 < lb) { const float vs = fexp(fminf(ref - as, 0.f));
#pragma unroll
                    for (int i = 0; i < 16; ++i) { const int l = lb * 32 + crow(i, hh); *(LAS unsigned short*)(lds + S_MM + l * LP + s * 2) = (unsigned short)f2bf(g0[i] * (ul[i] * vs)); }
                } else {
#pragma unroll
                    for (int i = 0; i < 16; ++i) { const int l = lb * 32 + crow(i, hh); const float e = fexp(fminf(al[i] - as, 0.f)); const float val = (s <= l) ? g0[i] * e : 0.f;
                        *(LAS unsigned short*)(lds + S_MM + l * LP + s * 2) = (unsigned short)f2bf(val); } } }
            if (sb0 + 1 <= lb) { const int s = (sb0 + 1) * 32 + r; const float as = ACS[s];
                if (sb0 + 1 < lb) { const float vs = fexp(fminf(ref - as, 0.f));
#pragma unroll
                    for (int i = 0; i < 16; ++i) { const int l = lb * 32 + crow(i, hh); *(LAS unsigned short*)(lds + S_MM + l * LP + s * 2) = (unsigned short)f2bf(g1[i] * (ul[i] * vs)); }
                } else {
#pragma unroll
                    for (int i = 0; i < 16; ++i) { const int l = lb * 32 + crow(i, hh); const float e = fexp(fminf(al[i] - as, 0.f)); const float val = (s <= l) ? g1[i] * e : 0.f;
                        *(LAS unsigned short*)(lds + S_MM + l * LP + s * 2) = (unsigned short)f2bf(val); } } }
        }
        {
            const float cd = fexp(ACS[127]);
#pragma unroll
            for (int i = 0; i < 16; ++i) sacc[i] *= cd;
            {
                const LAS unsigned char* ap = lds + S_XDDT + (pb * 32 + r) * LP; const int xsw = ((pb * 32 + r) >> 3) & 7;
                const LAS unsigned char* bp = lds + S_BC + (8 * hh) * LP + (yb * 32 + r) * 2;
#pragma unroll
                for (int kh = 0; kh < 2; ++kh) {
                    bf16x8 af[4], bfr[4];
#pragma unroll
                    for (int k4 = 0; k4 < 4; ++k4) { const int ks = kh * 4 + k4; af[k4] = *(const LAS bf16x8*)(ap + (((2 * ks + hh) ^ xsw) << 4));
#pragma unroll
                        for (int j = 0; j < 8; ++j) bfr[k4][j] = *(const LAS short*)(bp + (16 * ks + j) * LP); }
                    __builtin_amdgcn_sched_barrier(0);
#pragma unroll
                    for (int k4 = 0; k4 < 4; ++k4) sacc = __builtin_amdgcn_mfma_f32_32x32x16_bf16(af[k4], bfr[k4], sacc, 0, 0, 0);
                }
            }
        }
        __syncthreads();
        asm volatile("" :: "v"(pbc[0]), "v"(pbc[1]), "v"(pbc[2]), "v"(pbc[3]), "v"(pbc[4]), "v"(pbc[5]), "v"(pbc[6]), "v"(pbc[7]), "v"(pxv[0]), "v"(pxv[1]), "v"(pd0), "v"(pd1));
        {
            f32x4 ya[4];
#pragma unroll
            for (int q = 0; q < 4; ++q) ya[q] = (f32x4){0.f, 0.f, 0.f, 0.f};
            const LAS unsigned char* cap = lds + S_CC + (wave * 16 + yc) * LP + yg * 16;
            {
                bf16x8 af[4];
#pragma unroll
                for (int ks = 0; ks < 4; ++ks) af[ks] = *(const LAS bf16x8*)(cap + ks * 64);
#pragma unroll
                for (int q = 0; q < 4; ++q) { const LAS unsigned char* sbp = lds + S_SB + (4 * yc + q) * LP + yg * 16;
                    bf16x8 bfr[4];
#pragma unroll
                    for (int ks = 0; ks < 4; ++ks) bfr[ks] = *(const LAS bf16x8*)(sbp + ks * 64);
#pragma unroll
                    for (int ks = 0; ks < 4; ++ks) ya[q] = __builtin_amdgcn_mfma_f32_16x16x32_bf16(af[ks], bfr[ks], ya[q], 0, 0, 0); }
            }
            float ay[4];
#pragma unroll
            for (int i = 0; i < 4; ++i) ay[i] = fexp(ACS[wave * 16 + 4 * yg + i]);
#pragma unroll
            for (int q = 0; q < 4; ++q) { ya[q][0] *= ay[0]; ya[q][1] *= ay[1]; ya[q][2] *= ay[2]; ya[q][3] *= ay[3]; }
            {
                const LAS unsigned char* map = lds + S_MM + (wave * 16 + yc) * LP + yg * 16;
                const int nks = (wave >> 1) + 1;
                for (int ks = 0; ks < nks; ++ks) {
                    const bf16x8 am = *(const LAS bf16x8*)(map + ks * 64);
#pragma unroll
                    for (int q = 0; q < 4; ++q) { const int p = 4 * yc + q; const int xsw = (p >> 3) & 7;
                        const bf16x8 bx = *(const LAS bf16x8*)(lds + S_XDTT + p * LP + (((4 * ks + yg) ^ xsw) << 4));
                        ya[q] = __builtin_amdgcn_mfma_f32_16x16x32_bf16(am, bx, ya[q], 0, 0, 0); }
                }
            }
            u32x2 yo[4];
#pragma unroll
            for (int i = 0; i < 4; ++i) {
                const float z0 = bflo(zc[i].x), z1 = bfhi(zc[i].x), z2 = bflo(zc[i].y), z3 = bfhi(zc[i].y);
                const float x0 = bflo(xc[i].x), x1 = bfhi(xc[i].x), x2 = bflo(xc[i].y), x3 = bfhi(xc[i].y);
                yo[i].x = pk2((ya[0][i] + Dh * x0) * silu(z0), (ya[1][i] + Dh * x1) * silu(z1));
                yo[i].y = pk2((ya[2][i] + Dh * x2) * silu(z2), (ya[3][i] + Dh * x3) * silu(z3)); }
            __builtin_amdgcn_sched_barrier(0);
            const int yb0 = __builtin_amdgcn_readfirstlane((int)(((unsigned)rowbase + p0 + wave * 16) * 1024u * 2u));
            if (nvalid == 128) {
#pragma unroll
                for (int i = 0; i < 4; ++i) __builtin_amdgcn_raw_buffer_store_b64(__builtin_bit_cast(__attribute__((__vector_size__(2 * sizeof(unsigned)))) unsigned, yo[i]), yrs, yvoff, yb0 + i * 2048, 0);
            } else {
#pragma unroll
                for (int i = 0; i < 4; ++i) if (wave * 16 + 4 * yg + i < nvalid) __builtin_amdgcn_raw_buffer_store_b64(__builtin_bit_cast(__attribute__((__vector_size__(2 * sizeof(unsigned)))) unsigned, yo[i]), yrs, yvoff, yb0 + i * 2048, 0);
            }
        }
        if (wave == 7 && c + 1 < 33) SSD_SCAN(c + 1);
        __syncthreads();
#pragma unroll
        for (int i = 0; i < 16; ++i) *(LAS unsigned short*)(lds + S_SB + (pb * 32 + crow(i, hh)) * LP + (yb * 32 + r) * 2) = (unsigned short)f2bf(sacc[i]);
    }
#undef SSD_LOAD
#undef SSD_SCAN
    __syncthreads();
}

__device__ __forceinline__ void attn_item(const Params& P, int qi, int bh, int lane) {
    const int hd = bh & 15, b = bh >> 4;
    const bf16_t* PROJ = (const bf16_t*)(P.ws + WS_PROJ); bf16_t* OSB = (bf16_t*)P.out;
    const int r = lane & 31, hh = lane >> 5, t0 = 32 * qi, tq = t0 + r;
    const bool qvalid = tq < LL; const int tql = qvalid ? tq : LL - 1;
    const size_t rowbase = (size_t)b * LL;
    const bf16_t* qrow = PROJ + (rowbase + tql) * LDP + OFF_Q + hd * 64 + 8 * hh;
    bf16x8 qf[4];
#pragma unroll
    for (int ks = 0; ks < 4; ++ks) qf[ks] = __builtin_nontemporal_load((const bf16x8*)(qrow + 16 * ks));
    f32x16 o0, o1; for (int i = 0; i < 16; ++i) { o0[i] = 0.f; o1[i] = 0.f; }
    float run = 0.f;
    const float C2 = 0.125f * 1.4426950408889634f;
    bf16x8 kf[4], nkf[4], vb[4], nvb[4];
    const __amdgpu_buffer_rsrc_t prs = __builtin_amdgcn_make_buffer_rsrc((void*)PROJ, 0, 0x7fffffff, 0x00020000);
    const unsigned koff = (unsigned)(r * LDP + 8 * hh) * 2u, voff = (unsigned)(4 * hh * LDP + 2 * r) * 2u;
    const int kbase = (int)(((unsigned)rowbase * LDP + OFF_K + hd * 64) * 2u), vbase = (int)(((unsigned)rowbase * LDP + OFF_V + hd * 64) * 2u);
#define ATT_LOAD(KF, VB, kt_) do { const int _kt = __builtin_amdgcn_readfirstlane(kbase + 32 * (kt_) * (LDP * 2)), _vt = __builtin_amdgcn_readfirstlane(vbase + 32 * (kt_) * (LDP * 2)); \
        _Pragma("unroll") for (int ks = 0; ks < 4; ++ks) KF[ks] = __builtin_bit_cast(bf16x8, __builtin_amdgcn_raw_buffer_load_b128(prs, koff + 32 * ks, _kt, 0)); \
        _Pragma("unroll") for (int s = 0; s < 2; ++s) { _Pragma("unroll") for (int j = 0; j < 8; ++j) { const int _vr = _vt + (16 * s + 8 * (j >> 2) + (j & 3)) * (LDP * 2); \
            const unsigned _w = __builtin_amdgcn_raw_buffer_load_b32(prs, voff, _vr, 0); VB[2 * s][j] = (short)(_w & 0xffffu); VB[2 * s + 1][j] = (short)(_w >> 16); } } } while (0)
#define ATT_LOAD_CL(KF, VB, kt_) do { const int _s0 = 32 * (kt_); int _sk = _s0 + r; _sk = _sk < LL ? _sk : LL - 1; \
        const bf16_t* _kr = PROJ + (rowbase + _sk) * LDP + OFF_K + hd * 64 + 8 * hh; \
        _Pragma("unroll") for (int ks = 0; ks < 4; ++ks) KF[ks] = *(const bf16x8*)(_kr + 16 * ks); \
        _Pragma("unroll") for (int s = 0; s < 2; ++s) { _Pragma("unroll") for (int j = 0; j < 8; ++j) { int _key = _s0 + 16 * s + 8 * (j >> 2) + 4 * hh + (j & 3); _key = _key < LL ? _key : LL - 1; \
            const unsigned _w = *(const unsigned*)(PROJ + (rowbase + _key) * LDP + OFF_V + hd * 64 + 2 * r); VB[2 * s][j] = (short)(_w & 0xffffu); VB[2 * s + 1][j] = (short)(_w >> 16); } } } while (0)
    if (qi == 128) { ATT_LOAD_CL(kf, vb, qi); } else { ATT_LOAD(kf, vb, qi); }
    for (int kt = qi; kt >= 0; --kt) {
        const int s0 = 32 * kt;
        { const int ktn = kt > 0 ? kt - 1 : 0; ATT_LOAD(nkf, nvb, ktn); }
        f32x16 acc; for (int i = 0; i < 16; ++i) acc[i] = 0.f;
#pragma unroll
        for (int ks = 0; ks < 4; ++ks) acc = __builtin_amdgcn_mfma_f32_32x32x16_bf16(kf[ks], qf[ks], acc, 0, 0, 0);
        float sp[16], lb[16];
#pragma unroll
        for (int i = 0; i < 16; ++i) { const float z2 = acc[i] * C2;
            const float spv = fmaxf(z2, 0.f) + __builtin_amdgcn_logf(1.f + __builtin_amdgcn_exp2f(-fabsf(z2)));
            sp[i] = spv; lb[i] = z2 - spv; }
        if (kt == qi) {
#pragma unroll
            for (int i = 0; i < 16; ++i) { const bool valid = (s0 + crow(i, hh)) < tq; sp[i] = valid ? sp[i] : 0.f; lb[i] = valid ? lb[i] : -1e30f; }
        }
        float gs[4], og[4], tot[4];
#pragma unroll
        for (int gq = 0; gq < 4; ++gq) { gs[gq] = (sp[4 * gq] + sp[4 * gq + 1]) + (sp[4 * gq + 2] + sp[4 * gq + 3]); og[gq] = __shfl_xor(gs[gq], 32); tot[gq] = gs[gq] + og[gq]; }
        float later[4]; later[3] = 0.f; later[2] = tot[3]; later[1] = later[2] + tot[2]; later[0] = later[1] + tot[1];
        const float tile_sum = later[0] + tot[0];
        float w[16];
#pragma unroll
        for (int gq = 0; gq < 4; ++gq) { const float base = run + later[gq] + (hh == 0 ? og[gq] : 0.f);
            const float w3 = base, w2 = w3 + sp[4 * gq + 3], w1 = w2 + sp[4 * gq + 2], w0 = w1 + sp[4 * gq + 1];
            w[4 * gq + 3] = __builtin_amdgcn_exp2f(lb[4 * gq + 3] - w3); w[4 * gq + 2] = __builtin_amdgcn_exp2f(lb[4 * gq + 2] - w2);
            w[4 * gq + 1] = __builtin_amdgcn_exp2f(lb[4 * gq + 1] - w1); w[4 * gq + 0] = __builtin_amdgcn_exp2f(lb[4 * gq + 0] - w0); }
        run += tile_sum;
#pragma unroll
        for (int s = 0; s < 2; ++s) {
            u32x4 pa; pa.x = pk2(w[8 * s], w[8 * s + 1]); pa.y = pk2(w[8 * s + 2], w[8 * s + 3]); pa.z = pk2(w[8 * s + 4], w[8 * s + 5]); pa.w = pk2(w[8 * s + 6], w[8 * s + 7]);
            const bf16x8 af = __builtin_bit_cast(bf16x8, pa);
            o0 = __builtin_amdgcn_mfma_f32_32x32x16_bf16(af, vb[2 * s], o0, 0, 0, 0);
            o1 = __builtin_amdgcn_mfma_f32_32x32x16_bf16(af, vb[2 * s + 1], o1, 0, 0, 0);
        }
        if (__all((!qvalid) || (run >= 127.f))) break;
#pragma unroll
        for (int q = 0; q < 4; ++q) { kf[q] = nkf[q]; vb[q] = nvb[q]; }
    }
#undef ATT_LOAD
#undef ATT_LOAD_CL
#pragma unroll
    for (int i = 0; i < 16; ++i) { const int t = t0 + crow(i, hh);
        if (t < LL) *(unsigned*)(OSB + (rowbase + t) * 1024 + hd * 64 + 2 * r) = pk2(o0[i], o1[i]); }
}

#define XB_TMO      128
#define XB_XCNT(j)  (256  + 64 * (j))
#define XB_XSUB(j)  (1280 + 64 * (j))
#define XB_XGEN(j)  (2304 + 64 * (j))
#define XB_TOP      3328
#define XB_TOPGEN   3392
#define XCD_BAR_WORDS 3456
#define XB_SPIN_CAP (1u << 22)
__device__ __forceinline__ unsigned xb_ld(unsigned* p)              { return __hip_atomic_load(p, __ATOMIC_RELAXED, __HIP_MEMORY_SCOPE_AGENT); }
__device__ __forceinline__ unsigned xb_add(unsigned* p, unsigned v) { return __hip_atomic_fetch_add(p, v, __ATOMIC_RELAXED, __HIP_MEMORY_SCOPE_AGENT); }
__device__ __forceinline__ unsigned xb_xcc_id() { return (unsigned)__builtin_amdgcn_s_getreg((3 << 11) | 20) & 0xFu; }
#define XB_SPIN(cond, bar) do { unsigned _sp = 0; while (cond) { __builtin_amdgcn_s_sleep(1); \
    if ((++_sp & 255u) == 0u) { if (xb_ld(&(bar)[XB_TMO])) break; if (_sp > XB_SPIN_CAP) { atomicAdd(&(bar)[XB_TMO], 1u); break; } } } } while (0)
struct XcdBarrier { unsigned* bar; unsigned x; volatile LAS unsigned* st; };
__device__ __forceinline__ XcdBarrier xcd_barrier_post(unsigned* bar, volatile LAS unsigned* st) {
    XcdBarrier b; b.bar = bar; b.x = xb_xcc_id(); b.st = st;
    if (threadIdx.x == 0) (void)xb_add(&bar[XB_XCNT(b.x)], 1u);
    return b;
}
__device__ __forceinline__ void xcd_barrier_complete(unsigned* bar, unsigned x, unsigned& nloc, unsigned& nx) {
    const unsigned G = gridDim.x * gridDim.y * gridDim.z;
    unsigned sum, cnt, mine, sp = 0u;
    for (;;) {
        sum = 0u; cnt = 0u; mine = 0u;
#pragma unroll
        for (unsigned j = 0; j < 16; ++j) { const unsigned c = xb_ld(&bar[XB_XCNT(j)]); sum += c; cnt += (c > 0u) ? 1u : 0u; mine = (j == x) ? c : mine; }
        if (sum == G) break;
        __builtin_amdgcn_s_sleep(1);
        if ((++sp & 255u) == 0u) { if (xb_ld(&bar[XB_TMO])) break; if (sp > XB_SPIN_CAP) { atomicAdd(&bar[XB_TMO], 1u); break; } }
    }
    nloc = mine > 0u ? mine : 1u; nx = cnt > 0u ? cnt : 1u;
}
__device__ __forceinline__ void xcd_barrier(const XcdBarrier& b) {
    asm volatile("s_waitcnt vmcnt(0)" ::: "memory");
    __syncthreads();
    if (threadIdx.x == 0) {
        unsigned* bar = b.bar;
        __builtin_amdgcn_s_waitcnt(0);
        unsigned nloc = b.st[0], nx = b.st[1];
        if (nloc == 0u) { xcd_barrier_complete(bar, b.x, nloc, nx); b.st[0] = nloc; b.st[1] = nx; }
        const unsigned old = xb_add(&bar[XB_XSUB(b.x)], 1u);
        const unsigned gen = old / nloc;
        if (old + 1u == (gen + 1u) * nloc) {
            __builtin_amdgcn_fence(__ATOMIC_RELEASE, "agent");
            asm volatile("s_waitcnt vmcnt(0)" ::: "memory");
            const unsigned og = xb_add(&bar[XB_TOP], 1u);
            const unsigned tg = og / nx;
            if (og + 1u == (tg + 1u) * nx) xb_add(&bar[XB_TOPGEN], 1u);
            else XB_SPIN(xb_ld(&bar[XB_TOPGEN]) == tg, bar);
            __builtin_amdgcn_fence(__ATOMIC_ACQUIRE, "agent");
            xb_add(&bar[XB_XGEN(b.x)], 1u);
            asm volatile("s_waitcnt vmcnt(0)" ::: "memory");
        } else {
            XB_SPIN(xb_ld(&bar[XB_XGEN(b.x)]) == gen, bar);
            __builtin_amdgcn_fence(__ATOMIC_ACQUIRE, "agent");
            asm volatile("s_waitcnt vmcnt(0)" ::: "memory");
        }
    }
    __syncthreads();
}


__device__ __forceinline__ void thin_outproj(const bf16_t* A  , const bf16_t* Bt, bf16_t* C  , LAS unsigned char* lds, int bid, int G, int wave, int lane) {
    LAS f32x4* red = (LAS f32x4*)lds;
    for (int t2 = bid; t2 < 256; t2 += G) {
        const int tile = 2 * t2 + (wave >> 2), kq = wave & 3, rt = tile >> 6, ct = tile & 63;
        const bf16_t* ap = A + (size_t)(rt * 16 + (lane & 15)) * MIXW + kq * 512 + (lane >> 4) * 8;
        const bf16_t* bp = Bt + (size_t)(ct * 16 + (lane & 15)) * MIXW + kq * 512 + (lane >> 4) * 8;
        f32x4 acc = (f32x4){0.f, 0.f, 0.f, 0.f};
#pragma unroll
        for (int hb = 0; hb < 2; ++hb) {
            bf16x8 a[8], b[8];
#pragma unroll
            for (int k = 0; k < 8; ++k) { a[k] = *(const bf16x8*)(ap + (hb * 8 + k) * 32); b[k] = *(const bf16x8*)(bp + (hb * 8 + k) * 32); }
#pragma unroll
            for (int k = 0; k < 8; ++k) acc = __builtin_amdgcn_mfma_f32_16x16x32_bf16(a[k], b[k], acc, 0, 0, 0);
        }
        red[((wave >> 2) * 4 + kq) * 64 + lane] = acc;
        __syncthreads();
        if (kq == 0) {
            const LAS f32x4* rp = red + (wave >> 2) * 256 + lane;
            const f32x4 s = (rp[0] + rp[64]) + (rp[128] + rp[192]);
#pragma unroll
            for (int j = 0; j < 4; ++j) C[(size_t)(rt * 16 + (lane >> 4) * 4 + j) * 1024 + ct * 16 + (lane & 15)] = (bf16_t)f2bf(s[j]);
        }
        __syncthreads();
    }
}

__global__ void __launch_bounds__(NTHR, 2) hymba_fwd(Params P) {
    extern __shared__ __attribute__((aligned(16))) unsigned char lds_raw[];
    LAS unsigned char* lds = (LAS unsigned char*)lds_raw;
    cg::grid_group grid = cg::this_grid();
    if (threadIdx.x < 16) ((LAS unsigned*)(lds + LDS_MISC))[threadIdx.x] = 0u;
    __syncthreads();
    XcdBarrier xbar = xcd_barrier_post((unsigned*)P.ws, (volatile LAS unsigned*)(lds + LDS_MISC));
    const int tid = threadIdx.x, wave = __builtin_amdgcn_readfirstlane(tid >> 6); int lane = tid & 63;
    const int G = gridDim.x, bid = blockIdx.x;
    const int gw = bid * NWAVES + wave, NGW = G * NWAVES;
    const int gtid = bid * NTHR + tid, NGT = G * NTHR;
    unsigned char* ws = P.ws;
    bf16_t* WUP = (bf16_t*)(ws + WS_WUP); bf16_t* WDN = (bf16_t*)(ws + WS_WDN); bf16_t* WIN = (bf16_t*)(ws + WS_WIN); bf16_t* WOUT = (bf16_t*)(ws + WS_WOUT);
    bf16_t* PROJ = (bf16_t*)(ws + WS_PROJ);
    bf16_t* YSSD = (bf16_t*)(ws + WS_YSSD); bf16_t* MIXIN = (bf16_t*)(ws + WS_MIXIN); bf16_t* MIX = (bf16_t*)(ws + WS_MIX); bf16_t* FB = (bf16_t*)(ws + WS_FB); bf16_t* H1 = (bf16_t*)(ws + WS_H1);
    bf16_t* ACT = (bf16_t*)(ws + WS_ACT);
    bf16_t* XN = (bf16_t*)P.out + 4 * 1024;
    bf16_t* OSB = (bf16_t*)P.out;

    {
        LAS float* scr = (LAS float*)(lds + wave * 16384);
        constexpr int I_IN = 16 * 184, I_OUT = 32 * 32, I_UP = 16 * 176, I_DN = 44 * 32, NIT = I_IN + I_OUT + I_UP + I_DN;
        for (int it = gw; it < NIT; it += NGW) {
            int q = it;
            if (q < I_IN) { p0_transpose_item(P.w_in, 1024, INC, WIN, scr, q / 184, 32 * (q % 184), 32 * (q % 184), lane); continue; } q -= I_IN;
            if (q < I_OUT) { p0_transpose_item(P.w_out, 2048, 1024, WOUT, scr, q / 32, 32 * (q % 32), 32 * (q % 32), lane); continue; } q -= I_OUT;
            if (q < I_UP) { const int kb = q / 176, nb = q % 176, dn0 = 32 * nb, pn = dn0 >> 8, within = dn0 & 255;
                const int sn0 = (within < 128) ? (128 * pn + within) : (DFF + 128 * pn + within - 128);
                p0_transpose_item(P.w_up, 1024, NUP, WUP, scr, kb, sn0, dn0, lane); continue; } q -= I_UP;
            p0_transpose_item(P.w_down, DFF, 1024, WDN, scr, q / 32, 32 * (q % 32), 32 * (q % 32), lane);
        }
        for (int t0 = gw; t0 < TT; t0 += 2 * NGW) {
            f32x4 v[2][4]; int tt[2];
#pragma unroll
            for (int u = 0; u < 2; ++u) { const int t = t0 + u * NGW; tt[u] = t; const int tc = t < TT ? t : TT - 1;
                const int b = tc / LL, p = tc - b * LL;
                const float* src = (p < NMETA) ? P.meta + (size_t)p * 1024 : P.x + ((size_t)b * SEQ + p - NMETA) * 1024;
#pragma unroll
                for (int j = 0; j < 4; ++j) v[u][j] = __builtin_nontemporal_load((const f32x4*)src + lane + 64 * j); }
#pragma unroll
            for (int u = 0; u < 2; ++u) { const int t = tt[u];
                if (t < TT) rms_store_bf16(v[u], P.mix_pre_g, XN + (size_t)t * 1024, lane); }
        }
    }
    if (P.ws == nullptr) grid.sync();
    xcd_barrier(xbar);
    asm volatile("" : "+v"(lane));
    {
        pg8::Gemm g{XN, WIN, 131 * 256, NP1, 1024, 1024, 1024, 253, -3}; pg8::StaticOrder S; S.init(131 * 256, NP1, G, bid);
        pg8::EpiProjConv E{PROJ, P.conv_w, P.conv_b};
        pg8::gemm_phase<pg8::EpiProjConv, pg8::StaticOrder, true>(lds, g, S, E);
    }
    xcd_barrier(xbar);
    asm volatile("" : "+v"(lane));
    {
        constexpr int NA = NB * 16 * 129;
        const int nssdb = G > 128 ? 128 : G;
        constexpr int NA1 = NA;
        if (bid < nssdb) for (int it = bid; it < 128; it += nssdb) {
            const int xcd = it & 7, slot = it >> 3, pair = xcd * 2 + (slot >> 3), item = ((pair >> 1) << 4) + (pair & 1) * 8 + (slot & 7);
            ssd_item(P, lds, item, tid, wave, lane); }
        if (G > 128) {
            if (bid >= 128 && G == 256) {
                const int ab = bid - 128, xcd = ab & 7, ws = (ab >> 3) * NWAVES + wave;
                for (int j = ws; j < 16 * 129; j += 128) {
                    int qi, bi;
                    if (j < 16 * 127) { bi = j / 127; qi = 2 + (j - bi * 127); } else if (j < 16 * 128) { qi = 1; bi = j - 16 * 127; } else { qi = 0; bi = j - 16 * 128; }
                    attn_item(P, qi, xcd + 8 * bi, lane); }
            } else if (bid >= 128) { for (int it = (bid - 128) * NWAVES + wave; it < NA1; it += (G - 128) * NWAVES) attn_item(P, it % 129, it / 129, lane); }
            else { for (int it = NA1 + bid * NWAVES + wave; it < NA; it += 128 * NWAVES) attn_item(P, it % 129, it / 129, lane); }
        } else for (int it = gw; it < NA; it += NGW) attn_item(P, it % 129, it / 129, lane);
    }
    xcd_barrier(xbar);
    asm volatile("" : "+v"(lane));
    {
        for (int t0 = gw; t0 < TT; t0 += 4 * NGW) {
            u32x4 q[4][2][2]; int tt[4];
#pragma unroll
            for (int u = 0; u < 4; ++u) { const int t = t0 + u * NGW; tt[u] = t; const int tc = t < TT ? t : TT - 1;
#pragma unroll
                for (int half = 0; half < 2; ++half) { const bf16_t* src = (half ? OSB : YSSD) + (size_t)tc * 1024;
#pragma unroll
                    for (int j = 0; j < 2; ++j) q[u][half][j] = __builtin_nontemporal_load((const u32x4*)src + lane + 64 * j); } }
#pragma unroll
            for (int u = 0; u < 4; ++u) { const int t = tt[u]; if (t >= TT) continue;
                bf16_t* orow = MIXIN + (size_t)t * MIXW;
#pragma unroll
                for (int half = 0; half < 2; ++half) {
                    const float* gg = half ? P.sb_norm_g : P.ssd_norm_g;
                    float v[16]; float s = 0.f;
#pragma unroll
                    for (int j = 0; j < 2; ++j) { const u32x4 qq = q[u][half][j];
                        v[8 * j + 0] = bflo(qq.x); v[8 * j + 1] = bfhi(qq.x); v[8 * j + 2] = bflo(qq.y); v[8 * j + 3] = bfhi(qq.y); v[8 * j + 4] = bflo(qq.z); v[8 * j + 5] = bfhi(qq.z); v[8 * j + 6] = bflo(qq.w); v[8 * j + 7] = bfhi(qq.w); }
#pragma unroll
                    for (int j = 0; j < 16; ++j) s += v[j] * v[j];
                    const float rs = 1.f / sqrtf(wave_sum(s) * (1.f / 1024.f) + EPS);
#pragma unroll
                    for (int j = 0; j < 2; ++j) { const f32x4 ga = *(const f32x4*)(gg + 8 * lane + 512 * j), gb = *(const f32x4*)(gg + 8 * lane + 512 * j + 4); u32x4 w;
                        w.x = pk2(v[8 * j + 0] * rs * ga.x, v[8 * j + 1] * rs * ga.y); w.y = pk2(v[8 * j + 2] * rs * ga.z, v[8 * j + 3] * rs * ga.w);
                        w.z = pk2(v[8 * j + 4] * rs * gb.x, v[8 * j + 5] * rs * gb.y); w.w = pk2(v[8 * j + 6] * rs * gb.z, v[8 * j + 7] * rs * gb.w);
                        *((u32x4*)(orow + half * 1024) + lane + 64 * j) = w; }
                }
            }
        }
    }
    xcd_barrier(xbar);
    asm volatile("" : "+v"(lane));
    {
        thin_outproj(MIXIN + (size_t)(NB * SEQ) * MIXW, WOUT, MIX + (size_t)(NB * SEQ) * 1024, lds, bid, G, wave, lane);
        pg8::Gemm g{MIXIN, WOUT, NB * SEQ, 1024, MIXW, MIXW, MIXW, 256, 0}; pg8::StaticOrder S; S.init(NB * SEQ, 1024, G, bid);
        pg8::EpiBf16 E{MIX, 1024, 1024, MIX, 1024, 0, 0, 0};
        pg8::gemm_phase<pg8::EpiBf16, pg8::StaticOrder, true>(lds, g, S, E);
    }
    xcd_barrier(xbar);
    asm volatile("" : "+v"(lane));
    {
        for (int t0 = gw; t0 < TT; t0 += 2 * NGW) {
            f32x4 m[2][4], xv[2][4]; int tt[2];
#pragma unroll
            for (int u = 0; u < 2; ++u) { const int t = t0 + u * NGW; tt[u] = t; const int tc = t < TT ? t : TT - 1;
                const int b = tc / LL, p = tc - b * LL;
                const float* src = (p < NMETA) ? P.meta + (size_t)p * 1024 : P.x + ((size_t)b * SEQ + p - NMETA) * 1024;
#pragma unroll
                for (int j = 0; j < 4; ++j) { const u32x2 mq = __builtin_nontemporal_load((const u32x2*)(MIX + (size_t)tc * 1024) + lane + 64 * j);
                    m[u][j] = (f32x4){bflo(mq.x), bfhi(mq.x), bflo(mq.y), bfhi(mq.y)}; xv[u][j] = __builtin_nontemporal_load((const f32x4*)src + lane + 64 * j); } }
#pragma unroll
            for (int u = 0; u < 2; ++u) { const int t = tt[u]; if (t >= TT) continue;
                float s = 0.f; f32x4 hv[4];
#pragma unroll
                for (int j = 0; j < 4; ++j) s += (m[u][j].x * m[u][j].x + m[u][j].y * m[u][j].y) + (m[u][j].z * m[u][j].z + m[u][j].w * m[u][j].w);
                const float rs = 1.f / sqrtf(wave_sum(s) * (1.f / 1024.f) + EPS);
#pragma unroll
                for (int j = 0; j < 4; ++j) { const f32x4 gg = *((const f32x4*)P.mix_post_g + lane + 64 * j);
                    hv[j] = xv[u][j] + m[u][j] * rs * gg; u32x2 hq; hq.x = pk2(hv[j].x, hv[j].y); hq.y = pk2(hv[j].z, hv[j].w); __builtin_nontemporal_store(hq, (u32x2*)(H1 + (size_t)t * 1024) + lane + 64 * j); }
                rms_store_bf16(hv, P.ffn_pre_g, XN + (size_t)t * 1024, lane);
            }
        }
    }
    xcd_barrier(xbar);
    asm volatile("" : "+v"(lane));
    {
        pg8::Gemm g{XN, WUP, 130 * 256, NUP, 1024, 1024, 1024, 254, -2}; pg8::StaticOrder S; S.init(130 * 256, NUP, G, bid);
        pg8::EpiUpConv E{ACT, P.fconv_w, P.fconv_b};
        pg8::gemm_phase<pg8::EpiUpConv, pg8::StaticOrder, true>(lds, g, S, E);
    }
    xcd_barrier(xbar);
    asm volatile("" : "+v"(lane));
    {
        pg8::Gemm g{ACT, WDN, NB * SEQ, 1024, DFF, DFF, DFF, 256, 0}; pg8::StaticOrder S; S.init(NB * SEQ, 1024, G, bid);
        pg8::EpiBf16 E{FB, 1024, 1024, FB, 1024, 0, 0, 0};
        pg8::gemm_phase<pg8::EpiBf16, pg8::StaticOrder, true>(lds, g, S, E);
    }
    xcd_barrier(xbar);
    asm volatile("" : "+v"(lane));
    {
        for (int t0 = gw; t0 < NB * SEQ; t0 += 2 * NGW) {
            f32x4 f[2][4], hv[2][4];
#pragma unroll
            for (int u = 0; u < 2; ++u) { int tr = t0 + u * NGW; tr = tr < NB * SEQ ? tr : NB * SEQ - 1;
                const int b = tr / SEQ, s = tr - b * SEQ; const size_t t = (size_t)b * LL + NMETA + s;
#pragma unroll
                for (int j = 0; j < 4; ++j) { const u32x2 fq2 = __builtin_nontemporal_load((const u32x2*)(FB + (size_t)tr * 1024) + lane + 64 * j);
                    f[u][j] = (f32x4){bflo(fq2.x), bfhi(fq2.x), bflo(fq2.y), bfhi(fq2.y)}; const u32x2 hq = __builtin_nontemporal_load((const u32x2*)(H1 + t * 1024) + lane + 64 * j); hv[u][j] = (f32x4){bflo(hq.x), bfhi(hq.x), bflo(hq.y), bfhi(hq.y)}; } }
#pragma unroll
            for (int u = 0; u < 2; ++u) { const int tr = t0 + u * NGW; if (tr >= NB * SEQ) continue;
                float ss = 0.f;
#pragma unroll
                for (int j = 0; j < 4; ++j) ss += (f[u][j].x * f[u][j].x + f[u][j].y * f[u][j].y) + (f[u][j].z * f[u][j].z + f[u][j].w * f[u][j].w);
                const float rs = 1.f / sqrtf(wave_sum(ss) * (1.f / 1024.f) + EPS);
                f32x4* orow = (f32x4*)(P.out + (size_t)tr * 1024);
#pragma unroll
                for (int j = 0; j < 4; ++j) { const f32x4 gg = *((const f32x4*)P.ffn_post_g + lane + 64 * j); __builtin_nontemporal_store(hv[u][j] + f[u][j] * rs * gg, &orow[lane + 64 * j]); }
            }
        }
    }
}

extern "C" void kernel_launch(void* const* d_in, const int* in_sizes, int n_in, void* d_out, int out_size, void* d_ws, size_t ws_size, hipStream_t stream) {
    static int grid = 0;
    if (grid == 0) {
        if (n_in != 19 || ws_size < WS_NEED || out_size != NB * SEQ * DM) { fprintf(stderr, "kernel_launch: unexpected problem (n_in %d, ws %zu, out %d)\n", n_in, ws_size, out_size); grid = -1; return; }
        int dev = 0, cus = 0, per_cu = 0;
        hipGetDevice(&dev); hipDeviceGetAttribute(&cus, hipDeviceAttributeMultiprocessorCount, dev);
        if (hipFuncSetAttribute((const void*)hymba_fwd, hipFuncAttributeMaxDynamicSharedMemorySize, LDS_BYTES) != hipSuccess) { fprintf(stderr, "kernel_launch: hipFuncSetAttribute failed\n"); grid = -1; return; }
        if (hipOccupancyMaxActiveBlocksPerMultiprocessor(&per_cu, (const void*)hymba_fwd, NTHR, LDS_BYTES) != hipSuccess || per_cu < 1) { fprintf(stderr, "kernel_launch: occupancy query failed (%d)\n", per_cu); per_cu = 1; }
        (void)hipGetLastError();
        grid = cus * (per_cu > 1 ? 1 : per_cu);
    }
    if (grid < 0) return;
    Params p{};
    p.x = (const float*)d_in[0]; p.meta = (const float*)d_in[1]; p.mix_pre_g = (const float*)d_in[2]; p.w_in = (const float*)d_in[3]; p.conv_w = (const float*)d_in[4]; p.conv_b = (const float*)d_in[5];
    p.dt_bias = (const float*)d_in[6]; p.a_log = (const float*)d_in[7]; p.d_skip = (const float*)d_in[8]; p.ssd_norm_g = (const float*)d_in[9]; p.sb_norm_g = (const float*)d_in[10];
    p.w_out = (const float*)d_in[11]; p.mix_post_g = (const float*)d_in[12]; p.ffn_pre_g = (const float*)d_in[13]; p.w_up = (const float*)d_in[14]; p.fconv_w = (const float*)d_in[15];
    p.fconv_b = (const float*)d_in[16]; p.w_down = (const float*)d_in[17]; p.ffn_post_g = (const float*)d_in[18];
    p.out = (float*)d_out; p.ws = (unsigned char*)d_ws;
    if (hipMemsetAsync(d_ws, 0, XCD_BAR_WORDS * 4, stream) != hipSuccess) { fprintf(stderr, "kernel_launch: memset of the barrier words failed\n"); return; }
    void* args[] = {&p};
    hipError_t e = hipLaunchCooperativeKernel((const void*)hymba_fwd, dim3(grid), dim3(NTHR), args, LDS_BYTES, stream);
    if (e != hipSuccess) fprintf(stderr, "cooperative launch failed: %s (grid %d)\n", hipGetErrorString(e), grid);
}
```
